# Optimizing an MI355X kernel written in HIP

```python
import math
import jax
import jax.numpy as jnp
from jax import lax
import numpy as np

D_MODEL = 1024
BATCH = 2
SEQ = 16384
DEPTH = 1
DEC_BATCH = 32
DEC_SEQ = 32
PAST_LEN = 2048

CHUNK = 64
WINDOW = 128
HEAD_DIM = 64
MIX_W = D_MODEL // 2
N_HEADS = MIX_W // HEAD_DIM
N_KV_HEADS = N_HEADS // 4
KV_REP = N_HEADS // N_KV_HEADS
ATTN_W = N_HEADS * HEAD_DIM
KV_W = N_KV_HEADS * HEAD_DIM
SSM_GROUP = 16
SSM_W = MIX_W
SSM_GROUPS = SSM_W // SSM_GROUP
SSM_STATE = 64
MEM_LEN = 256
MEM_HEADS = 4
MEM_HEAD_DIM = MIX_W // MEM_HEADS
MEM_W = MEM_HEADS * MEM_HEAD_DIM
N_BRANCH = 3
IN_COLS = ATTN_W + 2 * KV_W + SSM_W + MEM_W + N_BRANCH * D_MODEL
D_FF = 128 * ((8 * D_MODEL // 3 + 127) // 128)
N_BUCKETS = 32
MAX_DISTANCE = 128
RMS_EPS = 1e-6
NEG_INF = -1e30
DT_MIN = 1e-3
DT_MAX = 1e-1

kernel_name = 'hybrid_streaming_encoder_step'


def rmsnorm(x, g):
    x32 = x.astype(jnp.float32)
    y = x32 * lax.rsqrt(jnp.mean(x32 * x32, axis=-1, keepdims=True) + RMS_EPS)
    return (y * g.astype(jnp.float32)).astype(x.dtype)


def swiglu(h, w_in, w_out):
    g, u = jnp.split(h @ w_in, 2, axis=-1)
    return (jax.nn.silu(g) * u) @ w_out


def t5_bucket(rel):
    half = N_BUCKETS // 2
    max_exact = half // 2
    ret = (rel > 0).astype(np.int32) * half
    n = np.abs(rel)
    large = max_exact + (np.log(np.maximum(n, 1) / max_exact) / math.log(MAX_DISTANCE / max_exact) * (half - max_exact)).astype(np.int32)
    large = np.minimum(large, half - 1)
    return ret + np.where(n < max_exact, n, large)


def band_bias(rel_table, n_q, n_back, n_k):
    i = np.arange(n_q)[:, None]
    j = np.arange(n_k)[None, :]
    bucket = t5_bucket((j - n_back) - i)
    b = rel_table[bucket].astype(jnp.float32)
    return jnp.transpose(b, (2, 0, 1)).reshape(N_KV_HEADS, KV_REP, n_q, n_k)


def sink_attention(q, k, v, bias, sink, key_valid=None):
    logits = jnp.einsum('...qgrd,...kgd->...grqk', q, k, preferred_element_type=jnp.float32) * (HEAD_DIM ** -0.5) + bias
    if key_valid is not None:
        logits = jnp.where(key_valid, logits, NEG_INF)
    sink_l = sink.astype(jnp.float32).reshape(N_KV_HEADS, KV_REP)[:, :, None, None]
    m = jnp.maximum(jnp.max(logits, axis=-1, keepdims=True), sink_l)
    e = jnp.exp(logits - m)
    p = e / (jnp.sum(e, axis=-1, keepdims=True) + jnp.exp(sink_l - m))
    return jnp.einsum('...grqk,...kgd->...qgrd', p.astype(v.dtype), v)


def swa_prompt(q, k, v, rel_table, sink):
    b, L = q.shape[0], q.shape[1]
    nc = L // CHUNK
    nb = WINDOW // CHUNK
    band = (nb + 1) * CHUNK
    qc = q.reshape(b, nc, CHUNK, N_KV_HEADS, KV_REP, HEAD_DIM)
    pad = ((0, 0), (WINDOW, 0), (0, 0), (0, 0))
    kc = jnp.pad(k, pad).reshape(b, nc + nb, CHUNK, N_KV_HEADS, HEAD_DIM)
    vc = jnp.pad(v, pad).reshape(b, nc + nb, CHUNK, N_KV_HEADS, HEAD_DIM)
    kb = jnp.concatenate([kc[:, s:s + nc] for s in range(nb + 1)], axis=2)
    vb = jnp.concatenate([vc[:, s:s + nc] for s in range(nb + 1)], axis=2)
    key_pos = np.arange(nc)[:, None] * CHUNK - WINDOW + np.arange(band)[None, :]
    valid = jnp.asarray(key_pos >= 0)[:, None, None, None, :]
    bias = band_bias(rel_table, CHUNK, WINDOW, band)
    out = sink_attention(qc, kb, vb, bias, sink, valid)
    return out.reshape(b, L, ATTN_W)


def swa_sample(q, k, v, k_cache, v_cache, rel_table, sink):
    b, s = q.shape[0], q.shape[1]
    n_back = k_cache.shape[1]
    kk = jnp.concatenate([k_cache.astype(k.dtype), k], axis=1)
    vv = jnp.concatenate([v_cache.astype(v.dtype), v], axis=1)
    bias = band_bias(rel_table, s, n_back, n_back + s)
    out = sink_attention(q, kk, vv, bias, sink)
    return out.reshape(b, s, ATTN_W)


def ssm_discretise(lam_re, lam_im, log_dt, b_re, b_im):
    f32 = jnp.float32
    dt = jnp.exp(log_dt.astype(f32))[:, None]
    lr, li = lam_re.astype(f32), lam_im.astype(f32)
    mag = jnp.exp(lr * dt)
    a_re, a_im = mag * jnp.cos(li * dt), mag * jnp.sin(li * dt)
    den = lr * lr + li * li
    coef_re = ((a_re - 1.0) * lr + a_im * li) / den
    coef_im = (a_im * lr - (a_re - 1.0) * li) / den
    br, bi = b_re.astype(f32), b_im.astype(f32)
    cr, ci = coef_re[..., None], coef_im[..., None]
    return a_re, a_im, cr * br - ci * bi, cr * bi + ci * br


def complex_affine_combine(e1, e2):
    a1r, a1i, b1r, b1i = e1
    a2r, a2i, b2r, b2i = e2
    return (a2r * a1r - a2i * a1i, a2r * a1i + a2i * a1r,
            a2r * b1r - a2i * b1i + b2r, a2r * b1i + a2i * b1r + b2i)


def ssm_branch(u, state, w):
    b, L, _ = u.shape
    f32 = jnp.float32
    ug = u.reshape(b, L, SSM_GROUPS, SSM_GROUP).astype(f32)
    a_re, a_im, bb_re, bb_im = ssm_discretise(w['ssm_lambda_re'], w['ssm_lambda_im'], w['ssm_log_dt'], w['ssm_b_re'], w['ssm_b_im'])
    bu_re = jnp.einsum('blgc,gpc->blgp', ug, bb_re)
    bu_im = jnp.einsum('blgc,gpc->blgp', ug, bb_im)
    shape = bu_re.shape
    elems = (jnp.broadcast_to(a_re, shape), jnp.broadcast_to(a_im, shape), bu_re, bu_im)
    ac_re, ac_im, s_re, s_im = lax.associative_scan(complex_affine_combine, elems, axis=1)
    if state is not None:
        s0_re = state[0].astype(f32)[:, None]
        s0_im = state[1].astype(f32)[:, None]
        s_re, s_im = (s_re + ac_re * s0_re - ac_im * s0_im, s_im + ac_re * s0_im + ac_im * s0_re)
    c_re, c_im = w['ssm_c_re'].astype(f32), w['ssm_c_im'].astype(f32)
    y = (jnp.einsum('blgp,gcp->blgc', s_re, c_re) - jnp.einsum('blgp,gcp->blgc', s_im, c_im)
         + w['ssm_d'].astype(f32) * ug)
    y = y.reshape(b, L, SSM_W).astype(u.dtype)
    ya, yb = jnp.split(y @ w['w_ssm_glu'], 2, axis=-1)
    return ya * jax.nn.sigmoid(yb), s_re[:, -1], s_im[:, -1]


def memory_kv(mem, g, w_kv):
    mk, mv = jnp.split(rmsnorm(mem, g) @ w_kv, 2, axis=-1)
    shape = mem.shape[:2] + (MEM_HEADS, MEM_HEAD_DIM)
    return mk.reshape(shape), mv.reshape(shape)


def cross_attention(q, mk, mv):
    logits = jnp.einsum('blhd,bmhd->bhlm', q, mk, preferred_element_type=jnp.float32) * (MEM_HEAD_DIM ** -0.5)
    p = jax.nn.softmax(logits, axis=-1).astype(mv.dtype)
    return jnp.einsum('bhlm,bmhd->blhd', p, mv)


def layer(x, mem_k, mem_v, swa_cache, ssm_state, rel_table, w):
    b, L, _ = x.shape
    x = x + 0.5 * rmsnorm(swiglu(rmsnorm(x, w['ff1_pre_g']), w['w_ff1_in'], w['w_ff1_out']), w['ff1_post_g'])
    h = rmsnorm(x, w['mix_pre_g'])
    cuts = np.cumsum([ATTN_W, KV_W, KV_W, SSM_W, MEM_W]).tolist()
    q, k, v, u, qm, gate_logits = jnp.split(h @ w['w_in'], cuts, axis=-1)
    q = q.reshape(b, L, N_KV_HEADS, KV_REP, HEAD_DIM)
    k = k.reshape(b, L, N_KV_HEADS, HEAD_DIM)
    v = v.reshape(b, L, N_KV_HEADS, HEAD_DIM)
    if swa_cache is None:
        attn = swa_prompt(q, k, v, rel_table, w['attn_sink'])
    else:
        attn = swa_sample(q, k, v, swa_cache[0], swa_cache[1], rel_table, w['attn_sink'])
    ssm_out, s_re, s_im = ssm_branch(u, ssm_state, w)
    mem_out = cross_attention(qm.reshape(b, L, MEM_HEADS, MEM_HEAD_DIM), mem_k.astype(x.dtype), mem_v.astype(x.dtype)).reshape(b, L, MEM_W)
    gates = jax.nn.sigmoid(gate_logits).reshape(b, L, N_BRANCH, D_MODEL)
    merged = (gates[:, :, 0] * (attn @ w['w_attn_br']) + gates[:, :, 1] * ssm_out
              + gates[:, :, 2] * (mem_out @ w['w_mem_br']))
    x = x + rmsnorm(merged @ w['w_out'], w['mix_post_g'])
    x = x + 0.5 * rmsnorm(swiglu(rmsnorm(x, w['ff2_pre_g']), w['w_ff2_in'], w['w_ff2_out']), w['ff2_post_g'])
    return x, k, v, s_re, s_im


def setup_inputs(seed: int = 0) -> dict:
    key = jax.random.key(seed)
    ks = iter(jax.random.split(key, 48))
    f32 = jnp.float32
    nrm = lambda shape, scale: scale * jax.random.normal(next(ks), shape, f32)
    gain = lambda shape: 1.0 + 0.02 * jax.random.normal(next(ks), shape, f32)
    n_back = min(WINDOW, PAST_LEN)
    lam_im_base = jnp.pi * jnp.arange(SSM_STATE, dtype=f32)
    return {
        'x_prompt': nrm((BATCH, SEQ, D_MODEL), 1.0),
        'x_sample': nrm((DEC_BATCH, DEC_SEQ, D_MODEL), 1.0),
        'cache_swa_k': nrm((DEPTH, DEC_BATCH, n_back, N_KV_HEADS, HEAD_DIM), 1.0),
        'cache_swa_v': nrm((DEPTH, DEC_BATCH, n_back, N_KV_HEADS, HEAD_DIM), 1.0),
        'cache_mem_k': nrm((DEPTH, DEC_BATCH, MEM_LEN, MEM_HEADS, MEM_HEAD_DIM), 1.0),
        'cache_mem_v': nrm((DEPTH, DEC_BATCH, MEM_LEN, MEM_HEADS, MEM_HEAD_DIM), 1.0),
        'state_ssm_re': nrm((DEPTH, DEC_BATCH, SSM_GROUPS, SSM_STATE), 0.1),
        'state_ssm_im': nrm((DEPTH, DEC_BATCH, SSM_GROUPS, SSM_STATE), 0.1),
        'mem_prompt': nrm((BATCH, MEM_LEN, D_MODEL), 1.0),
        'rel_bias_table': nrm((N_BUCKETS, N_HEADS), 0.2),
        'ff1_pre_g': gain((DEPTH, D_MODEL)),
        'ff1_post_g': gain((DEPTH, D_MODEL)),
        'w_ff1_in': nrm((DEPTH, D_MODEL, 2 * D_FF), D_MODEL ** -0.5),
        'w_ff1_out': nrm((DEPTH, D_FF, D_MODEL), D_FF ** -0.5),
        'mix_pre_g': gain((DEPTH, D_MODEL)),
        'mix_post_g': gain((DEPTH, D_MODEL)),
        'w_in': nrm((DEPTH, D_MODEL, IN_COLS), D_MODEL ** -0.5),
        'mem_norm_g': gain((DEPTH, D_MODEL)),
        'w_mem_kv': nrm((DEPTH, D_MODEL, 2 * MEM_W), D_MODEL ** -0.5),
        'attn_sink': nrm((DEPTH, N_HEADS), 0.5),
        'ssm_lambda_re': -0.5 + nrm((DEPTH, SSM_GROUPS, SSM_STATE), 0.01),
        'ssm_lambda_im': lam_im_base + nrm((DEPTH, SSM_GROUPS, SSM_STATE), 0.01),
        'ssm_log_dt': jax.random.uniform(next(ks), (DEPTH, SSM_GROUPS), f32, math.log(DT_MIN), math.log(DT_MAX)),
        'ssm_b_re': nrm((DEPTH, SSM_GROUPS, SSM_STATE, SSM_GROUP), (2 * SSM_GROUP) ** -0.5),
        'ssm_b_im': nrm((DEPTH, SSM_GROUPS, SSM_STATE, SSM_GROUP), (2 * SSM_GROUP) ** -0.5),
        'ssm_c_re': nrm((DEPTH, SSM_GROUPS, SSM_GROUP, SSM_STATE), SSM_STATE ** -0.5),
        'ssm_c_im': nrm((DEPTH, SSM_GROUPS, SSM_GROUP, SSM_STATE), SSM_STATE ** -0.5),
        'ssm_d': nrm((DEPTH, SSM_GROUPS, SSM_GROUP), 1.0),
        'w_ssm_glu': nrm((DEPTH, SSM_W, 2 * D_MODEL), SSM_W ** -0.5),
        'w_attn_br': nrm((DEPTH, ATTN_W, D_MODEL), ATTN_W ** -0.5),
        'w_mem_br': nrm((DEPTH, MEM_W, D_MODEL), MEM_W ** -0.5),
        'w_out': nrm((DEPTH, D_MODEL, D_MODEL), D_MODEL ** -0.5),
        'ff2_pre_g': gain((DEPTH, D_MODEL)),
        'ff2_post_g': gain((DEPTH, D_MODEL)),
        'w_ff2_in': nrm((DEPTH, D_MODEL, 2 * D_FF), D_MODEL ** -0.5),
        'w_ff2_out': nrm((DEPTH, D_FF, D_MODEL), D_FF ** -0.5),
    }


def reference(x_prompt, x_sample, cache_swa_k, cache_swa_v, cache_mem_k, cache_mem_v,
              state_ssm_re, state_ssm_im, mem_prompt, rel_bias_table,
              ff1_pre_g, ff1_post_g, w_ff1_in, w_ff1_out, mix_pre_g, mix_post_g, w_in,
              mem_norm_g, w_mem_kv, attn_sink, ssm_lambda_re, ssm_lambda_im, ssm_log_dt,
              ssm_b_re, ssm_b_im, ssm_c_re, ssm_c_im, ssm_d, w_ssm_glu, w_attn_br, w_mem_br,
              w_out, ff2_pre_g, ff2_post_g, w_ff2_in, w_ff2_out):
    yp, ys = x_prompt, x_sample
    pk_l, pv_l, pmk_l, pmv_l, pre_l, pim_l = [], [], [], [], [], []
    sk_l, sv_l, sre_l, sim_l = [], [], [], []
    for l in range(DEPTH):
        w = dict(ff1_pre_g=ff1_pre_g[l], ff1_post_g=ff1_post_g[l], w_ff1_in=w_ff1_in[l], w_ff1_out=w_ff1_out[l],
                 mix_pre_g=mix_pre_g[l], mix_post_g=mix_post_g[l], w_in=w_in[l], attn_sink=attn_sink[l],
                 ssm_lambda_re=ssm_lambda_re[l], ssm_lambda_im=ssm_lambda_im[l], ssm_log_dt=ssm_log_dt[l],
                 ssm_b_re=ssm_b_re[l], ssm_b_im=ssm_b_im[l], ssm_c_re=ssm_c_re[l], ssm_c_im=ssm_c_im[l],
                 ssm_d=ssm_d[l], w_ssm_glu=w_ssm_glu[l], w_attn_br=w_attn_br[l], w_mem_br=w_mem_br[l],
                 w_out=w_out[l], ff2_pre_g=ff2_pre_g[l], ff2_post_g=ff2_post_g[l],
                 w_ff2_in=w_ff2_in[l], w_ff2_out=w_ff2_out[l])
        mk, mv = memory_kv(mem_prompt, mem_norm_g[l], w_mem_kv[l])
        yp, pk, pv, pre, pim = layer(yp, mk, mv, None, None, rel_bias_table, w)
        ys, sk, sv, sre, sim = layer(ys, cache_mem_k[l], cache_mem_v[l], (cache_swa_k[l], cache_swa_v[l]),
                                     (state_ssm_re[l], state_ssm_im[l]), rel_bias_table, w)
        n_keep = min(WINDOW, pk.shape[1])
        pk_l.append(pk[:, -n_keep:])
        pv_l.append(pv[:, -n_keep:])
        pmk_l.append(mk)
        pmv_l.append(mv)
        pre_l.append(pre)
        pim_l.append(pim)
        sk_l.append(sk)
        sv_l.append(sv)
        sre_l.append(sre)
        sim_l.append(sim)
    return (yp, ys, jnp.stack(pk_l), jnp.stack(pv_l), jnp.stack(pmk_l), jnp.stack(pmv_l),
            jnp.stack(pre_l), jnp.stack(pim_l), jnp.stack(sk_l), jnp.stack(sv_l),
            jnp.stack(sre_l), jnp.stack(sim_l))
```

```cpp
#include <hip/hip_runtime.h>
#include <hip/hip_cooperative_groups.h>
#include <cstdio>
#include <cstdint>
namespace cg = cooperative_groups;

#define LAS __attribute__((address_space(3)))
typedef unsigned short bf16_t;
typedef short bf16x8 __attribute__((ext_vector_type(8)));
typedef short s16x4 __attribute__((ext_vector_type(4)));
typedef float f32x4 __attribute__((ext_vector_type(4)));
typedef float f32x16 __attribute__((ext_vector_type(16)));
typedef unsigned u32x4 __attribute__((ext_vector_type(4)));
typedef unsigned u32x2 __attribute__((ext_vector_type(2)));

constexpr int DM = 1024, TP = 32768, TS = 1024, MT = TP + TS, SEQ = 16384, DFF = 2816, NIN = 4864;
constexpr int NCH = MT / 32  , NCHP = 1280  , UGW = 640  ;
constexpr float RMS_EPS = 1e-6f, LOG2E = 1.4426950408889634f;
constexpr float QSCALE = 0.125f * LOG2E, MSCALE = 0.08838834764831845f * LOG2E;

constexpr size_t OUT_Y = 0, OUT_KP = 34603008, OUT_VP = 34635776, OUT_MKP = 34668544, OUT_MVP = 34930688, OUT_SRP = 35192832, OUT_SIP = 35196928,
                 OUT_KS = 35201024, OUT_VS = 35332096, OUT_SRS = 35463168, OUT_SIS = 35528704, OUT_TOTAL = 35594240;

constexpr size_t WS_CTL = 0, CTL_BYTES = 1048576;
constexpr size_t WS_W1A = WS_CTL + CTL_BYTES;
constexpr size_t WS_W1B = WS_W1A + (size_t)5632 * 1024 * 2;
constexpr size_t WS_W2A = WS_W1B + (size_t)1024 * 2816 * 2;
constexpr size_t WS_W2B = WS_W2A + (size_t)5632 * 1024 * 2;
constexpr size_t WS_WIN = WS_W2B + (size_t)1024 * 2816 * 2;
constexpr size_t WS_WBA = WS_WIN + (size_t)4864 * 1024 * 2;
constexpr size_t WS_WBM = WS_WBA + (size_t)1024 * 512 * 2;
constexpr size_t WS_WBG = WS_WBM + (size_t)1024 * 512 * 2;
constexpr size_t WS_WOUT = WS_WBG + (size_t)2048 * 512 * 2;
constexpr size_t WS_WMKV = WS_WOUT + (size_t)1024 * 1024 * 2;
constexpr size_t WS_TG = WS_WMKV + (size_t)1024 * 1024 * 2;
constexpr size_t WS_MG = WS_TG + (size_t)32 * 512 * 640 * 2;
constexpr size_t WS_TAB = WS_MG + (size_t)32 * 256 * 512 * 2;
constexpr size_t TAB_POW = 0;
constexpr size_t TAB_BBAR = TAB_POW + (size_t)32 * 64 * 33 * 8;
constexpr size_t TAB_KTAB = TAB_BBAR + (size_t)32 * 64 * 16 * 8;
constexpr size_t TAB_BIAS = TAB_KTAB + (size_t)32 * 32 * 256 * 4;
constexpr size_t TAB_END = TAB_BIAS + 8 * 256 * 4 + 64;
static_assert(TAB_END <= 2097152, "tables");
constexpr size_t WS_MEMN = WS_TAB + 2097152;
constexpr size_t WS_MKV = WS_MEMN + (size_t)512 * 1024 * 2;
constexpr size_t WS_XN = WS_MKV + (size_t)512 * 1024 * 2;
constexpr size_t WS_BIG = WS_XN + (size_t)MT * 1024 * 2;
constexpr size_t BG_UG = 0;
constexpr size_t BG_KK = BG_UG + (size_t)32 * NCHP * UGW * 2;
constexpr size_t BG_VV = BG_KK + (size_t)MT * 128 * 2;
constexpr size_t BG_LE = BG_VV + (size_t)MT * 128 * 2;
constexpr size_t BG_Q = BG_LE + (size_t)32 * NCHP * 128 * 4;
constexpr size_t BG_QM = BG_Q + (size_t)MT * 512 * 2;
constexpr size_t BG_GATES = BG_QM + (size_t)MT * 512 * 2;
constexpr size_t BG_END = BG_GATES + (size_t)MT * 3072 * 2;
constexpr size_t BG_MERGED = 0;
static_assert((size_t)MT * 1024 * 2 <= BG_Q, "MERGED overlay");
constexpr size_t BG_ACT = 0;
constexpr size_t BG_O = BG_ACT + (size_t)MT * DFF * 2;
static_assert(BG_O >= BG_GATES && BG_O + (size_t)MT * 1024 * 4 <= BG_END, "O f32 must sit inside the (dead) gates region while MERGED is read");
constexpr size_t WS_END = WS_BIG + BG_END;
static_assert(WS_END <= (size_t)512 * 1048576, "workspace");
constexpr int CW_Q0 = 64, CW_Q1 = 128;
constexpr int CW_DIAG = 1024;

constexpr int RING_BYTES = 131072, MISC_OFF = RING_BYTES, LDS_BYTES = 147456;
constexpr int NTHREADS = 512, NWAVES = 8;

typedef float f32x2_t __attribute__((ext_vector_type(2))); typedef __bf16 bf16x2_t __attribute__((ext_vector_type(2)));
__device__ __forceinline__ unsigned cvt_pk_bf16(float lo, float hi) { f32x2_t v = {lo, hi}; bf16x2_t b = __builtin_convertvector(v, bf16x2_t); return __builtin_bit_cast(unsigned, b); }
__device__ __forceinline__ float bf_lo(unsigned w) { return __uint_as_float(w << 16); }
__device__ __forceinline__ float bf_hi(unsigned w) { return __uint_as_float(w & 0xffff0000u); }
__device__ __forceinline__ float bf2f(bf16_t h) { return __uint_as_float((unsigned)h << 16); }
__device__ __forceinline__ float wave_sum(float v) {
#pragma unroll
    for (int o = 1; o < 64; o <<= 1) v += __shfl_xor(v, o);
    return v;
}
__device__ __forceinline__ float fast_exp2(float x) { return __builtin_amdgcn_exp2f(x); }
__device__ __forceinline__ float fast_rcp(float x) { return __builtin_amdgcn_rcpf(x); }
__device__ __forceinline__ float sigmoidf_(float x) { return fast_rcp(1.0f + fast_exp2(-x * LOG2E)); }
#define LDS_WAIT() asm volatile("s_waitcnt lgkmcnt(0)" ::: "memory")

__device__ const unsigned char T5_BUCKET[255] = {
15,15,15,15,15,15,15,15,15,15,15,15,15,15,15,15,15,15,15,15,15,15,15,15,15,15,15,15,15,15,15,15,15,15,15,15,15,15,15,15,15,15,15,15,15,15,15,15,15,15,15,15,15,15,15,15,15,15,15,15,15,15,15,15,15,15,15,15,15,15,15,15,15,15,15,15,15,15,15,15,15,15,15,15,15,15,15,15,15,15,15,15,15,15,15,15,15,15,15,15,15,14,14,14,14,14,14,14,14,14,14,14,14,14,14,14,14,14,14,14,14,14,14,14,14,14,14,14,13,13,13,13,13,13,13,13,13,13,13,13,13,13,13,13,13,13,12,12,12,12,12,12,12,12,12,12,12,12,12,12,11,11,11,11,11,11,11,11,11,10,10,10,10,10,10,10,9,9,9,9,8,8,8,8,7,6,5,4,3,2,1,0,17,18,19,20,21,22,23,24,24,24,24,25,25,25,25,26,26,26,26,26,26,26,27,27,27,27,27,27,27,27,27,28,28,28,28,28,28,28,28,28,28,28,28,28,28,29,29,29,29,29,29,29,29,29,29,29,29,29,29,29,29,29,29};

namespace pg8 {
#define PG8_LAS __attribute__((address_space(3)))
constexpr int BM = 256, BK = 64, HALF = 128, HTB = HALF * BK * 2, STAGE_BYTES = 8 * HTB, NXCD = 8, WGM = 8;
__host__ __device__ __forceinline__ int lds_byte(int r, int c) { const int st = (r >> 4) * 2 + (c >> 5), rr = r & 15, cc = c & 31, ob = rr * 64 + cc * 2; return st * 1024 + (ob ^ (((ob >> 9) & 1) << 5)); }
__host__ __device__ __forceinline__ void stage_rc(int b, int& R, int& C) { const int st = b / 1024, sb = b % 1024, swz = sb ^ (((sb >> 9) & 1) << 5); R = (st >> 1) * 16 + swz / 64; C = (st & 1) * 32 + (swz % 64) / 2; }
__host__ __device__ __forceinline__ int perm32(int rho) { const int n = rho >> 4, i = rho & 15; return 8 * (i >> 2) + 4 * n + (i & 3); }
struct Unit { int pm, pn, z; };
template <class Epi, class Sched, bool ALIGN_EPI = true, bool SP2 = true>
__device__ __forceinline__ void gemm_phase(PG8_LAS unsigned char* lds, const int K, const int lda, const int ldb, const Sched& S, const Epi& E) {
    int tid_ = threadIdx.x; asm volatile("" : "+v"(tid_)); const int tid = tid_, wid = __builtin_amdgcn_readfirstlane(tid >> 6), lane = tid & 63, wr = wid >> 2, wc = wid & 3, fr = lane & 15, fq = lane >> 4;
    const int nt = K / BK;
    unsigned voffA[2], voffB[2];
#pragma unroll
    for (int i = 0; i < 2; ++i) { int R, C; stage_rc(tid * 16 + i * 8192, R, C); const int Rb = Epi::PERM ? ((R & ~31) + perm32(R & 31)) : R;
        voffA[i] = (unsigned)(R * lda + C) * 2u; voffB[i] = (unsigned)(Rb * ldb + C) * 2u; }
    const size_t kstep = (size_t)(BK * 2);
    const size_t hstepA = (size_t)HALF * lda * 2, hstepB = (size_t)HALF * ldb * 2;
    const unsigned ldsw = (unsigned)wid * 1024u;
    const int aoff = lds_byte(wr * 64 + fr, fq * 8), boff = lds_byte(wc * 32 + fr, fq * 8);
#define PG8_SA(b, h) (((b) * 2 + (h)) * HTB)
#define PG8_SB(b, h) ((4 + (b) * 2 + (h)) * HTB)
#define PG8_STAGE(bufoff, gbase, voff) do { _Pragma("unroll") for (int _i = 0; _i < 2; ++_i) \
        __builtin_amdgcn_global_load_lds((const unsigned*)((const char*)(gbase) + (voff)[_i]), (PG8_LAS unsigned*)(lds + (bufoff) + ldsw + _i * 8192), 16, 0, 0); } while (0)
#define PG8_LDA(dst, b, h) do { _Pragma("unroll") for (int m = 0; m < 4; ++m) _Pragma("unroll") for (int k = 0; k < 2; ++k) dst[m][k] = *(const PG8_LAS bf16x8*)(lds + PG8_SA(b, h) + aoff + m * 2048 + k * 1024); } while (0)
#define PG8_LDB(dst, b, h) do { _Pragma("unroll") for (int n = 0; n < 2; ++n) _Pragma("unroll") for (int k = 0; k < 2; ++k) dst[n][k] = *(const PG8_LAS bf16x8*)(lds + PG8_SB(b, h) + boff + n * 2048 + k * 1024); } while (0)
#define PG8_MMA(ai, bj, At, Bt) do { __builtin_amdgcn_s_setprio(1); _Pragma("unroll") for (int m = 0; m < 4; ++m) _Pragma("unroll") for (int n = 0; n < 2; ++n) _Pragma("unroll") for (int k = 0; k < 2; ++k) \
        acc[ai][bj][m][n] = __builtin_amdgcn_mfma_f32_16x16x32_bf16(Bt[n][k], At[m][k], acc[ai][bj][m][n], 0, 0, 0); __builtin_amdgcn_s_setprio(0); } while (0)
#define PG8_WAIT_V(n) asm volatile("s_waitcnt vmcnt(" #n ")" ::: "memory")
#define PG8_WAIT_L(n) asm volatile("s_waitcnt lgkmcnt(" #n ")" ::: "memory")
#define PG8_BAR __builtin_amdgcn_s_barrier()
#define PG8_SCHED __builtin_amdgcn_sched_barrier(0)
    Unit cur, nxt; int ui = 0;
    if (!S.next(0, cur)) return;
    f32x4 acc[2][2][4][2];
#pragma unroll
    for (int a = 0; a < 2; ++a)
#pragma unroll
        for (int b = 0; b < 2; ++b)
#pragma unroll
            for (int m = 0; m < 4; ++m)
#pragma unroll
                for (int n = 0; n < 2; ++n) acc[a][b][m][n] = (f32x4){0.f, 0.f, 0.f, 0.f};
    bf16x8 At[4][2], B0[2][2], B1[2][2];
    const char* cA = S.Aof(cur); const char* cB = S.Bof(cur);
    if constexpr (SP2) {
        PG8_STAGE(PG8_SB(0, 0), cB, voffB); PG8_STAGE(PG8_SB(0, 1), cB + hstepB, voffB); PG8_STAGE(PG8_SA(0, 0), cA, voffA); PG8_STAGE(PG8_SA(0, 1), cA + hstepA, voffA);
        if (wr == 1) PG8_BAR;
        PG8_WAIT_V(2); PG8_BAR;
        PG8_STAGE(PG8_SB(1, 0), cB + kstep, voffB); PG8_STAGE(PG8_SA(1, 0), cA + kstep, voffA); PG8_STAGE(PG8_SB(1, 1), cB + hstepB + kstep, voffB);
        PG8_WAIT_V(6); PG8_BAR;
    } else {
        PG8_STAGE(PG8_SB(0, 0), cB, voffB); PG8_STAGE(PG8_SA(0, 0), cA, voffA); PG8_STAGE(PG8_SB(0, 1), cB + hstepB, voffB); PG8_STAGE(PG8_SA(0, 1), cA + hstepA, voffA);
        if (wr == 1) PG8_BAR;
        PG8_WAIT_V(4); PG8_BAR;
        PG8_STAGE(PG8_SB(1, 0), cB + kstep, voffB); PG8_STAGE(PG8_SA(1, 0), cA + kstep, voffA); PG8_STAGE(PG8_SB(1, 1), cB + hstepB + kstep, voffB);
        PG8_WAIT_V(6); PG8_BAR;
    }
    for (;;) {
        const bool has_next = S.next(ui + 1, nxt);
        const char* nA = has_next ? S.Aof(nxt) : cA; const char* nB = has_next ? S.Bof(nxt) : cB;
        for (int t = 0; t < nt; t += 2) {
            const bool last = (t == nt - 2);
            const char* a1 = cA + (size_t)(t + 1) * kstep;
            const char* a2 = last ? nA : cA + (size_t)(t + 2) * kstep; const char* b2 = last ? nB : cB + (size_t)(t + 2) * kstep;
            const char* a3 = a2 + kstep; const char* b3 = b2 + kstep;
            if constexpr (SP2) {
            PG8_LDB(B0, 0, 0); PG8_LDB(B1, 0, 1); PG8_SCHED; PG8_LDA(At, 0, 0); PG8_STAGE(PG8_SA(1, 1), a1 + hstepA, voffA);
            PG8_WAIT_V(8); PG8_WAIT_L(0); PG8_BAR; PG8_MMA(0, 0, At, B0); PG8_MMA(0, 1, At, B1); PG8_BAR; PG8_SCHED;
            PG8_LDA(At, 0, 1); PG8_STAGE(PG8_SB(0, 0), b2, voffB); PG8_STAGE(PG8_SB(0, 1), b2 + hstepB, voffB); PG8_STAGE(PG8_SA(0, 0), a2, voffA);
            PG8_WAIT_V(8); PG8_WAIT_L(0); PG8_BAR; PG8_MMA(1, 0, At, B0); PG8_MMA(1, 1, At, B1); PG8_BAR; PG8_SCHED;
            PG8_LDB(B0, 1, 0); PG8_LDB(B1, 1, 1); PG8_SCHED; PG8_LDA(At, 1, 0); PG8_STAGE(PG8_SA(0, 1), a2 + hstepA, voffA);
            PG8_WAIT_V(8); PG8_WAIT_L(0); PG8_BAR; PG8_MMA(0, 0, At, B0); PG8_MMA(0, 1, At, B1); PG8_BAR; PG8_SCHED;
            PG8_LDA(At, 1, 1); PG8_STAGE(PG8_SB(1, 0), b3, voffB); PG8_STAGE(PG8_SB(1, 1), b3 + hstepB, voffB); PG8_STAGE(PG8_SA(1, 0), a3, voffA);
            PG8_WAIT_V(8); PG8_WAIT_L(0); PG8_BAR; PG8_MMA(1, 0, At, B0); PG8_MMA(1, 1, At, B1); PG8_BAR; PG8_SCHED;
            } else {
            PG8_LDB(B0, 0, 0); PG8_SCHED; PG8_LDA(At, 0, 0); PG8_STAGE(PG8_SA(1, 1), a1 + hstepA, voffA);
            PG8_WAIT_L(8); PG8_BAR; PG8_WAIT_L(0); PG8_MMA(0, 0, At, B0); PG8_BAR; PG8_SCHED;
            PG8_LDB(B1, 0, 1); PG8_STAGE(PG8_SB(0, 0), b2, voffB);
            PG8_BAR; PG8_WAIT_L(0); PG8_MMA(0, 1, At, B1); PG8_BAR;
            PG8_LDA(At, 0, 1); PG8_STAGE(PG8_SA(0, 0), a2, voffA);
            PG8_BAR; PG8_WAIT_L(0); PG8_MMA(1, 0, At, B0); PG8_BAR; PG8_SCHED;
            PG8_STAGE(PG8_SB(0, 1), b2 + hstepB, voffB);
            PG8_WAIT_V(6); PG8_BAR; PG8_MMA(1, 1, At, B1); PG8_BAR;
            PG8_LDB(B0, 1, 0); PG8_SCHED; PG8_LDA(At, 1, 0); PG8_STAGE(PG8_SA(0, 1), a2 + hstepA, voffA);
            PG8_WAIT_L(8); PG8_BAR; PG8_WAIT_L(0); PG8_MMA(0, 0, At, B0); PG8_BAR; PG8_SCHED;
            PG8_LDB(B1, 1, 1); PG8_STAGE(PG8_SB(1, 0), b3, voffB);
            PG8_BAR; PG8_WAIT_L(0); PG8_MMA(0, 1, At, B1); PG8_BAR;
            PG8_LDA(At, 1, 1); PG8_STAGE(PG8_SA(1, 0), a3, voffA);
            PG8_BAR; PG8_WAIT_L(0); PG8_MMA(1, 0, At, B0); PG8_BAR; PG8_SCHED;
            PG8_STAGE(PG8_SB(1, 1), b3 + hstepB, voffB);
            PG8_WAIT_V(6); PG8_BAR; PG8_MMA(1, 1, At, B1); PG8_BAR;
            }
        }
        if constexpr (ALIGN_EPI) { if (wr == 0) PG8_BAR; }
        E(acc, cur, wr, wc, fr, fq);
        if (!has_next) break;
#pragma unroll
        for (int a = 0; a < 2; ++a)
#pragma unroll
            for (int b = 0; b < 2; ++b)
#pragma unroll
                for (int m = 0; m < 4; ++m)
#pragma unroll
                    for (int n = 0; n < 2; ++n) acc[a][b][m][n] = (f32x4){0.f, 0.f, 0.f, 0.f};
        cur = nxt; cA = nA; cB = nB; ++ui;
        if constexpr (ALIGN_EPI) { if (wr == 1) PG8_BAR; }
    }
    PG8_WAIT_V(0);
    if constexpr (!ALIGN_EPI) { if (wr == 0) PG8_BAR; }
    PG8_BAR;
#undef PG8_SA
#undef PG8_SB
#undef PG8_STAGE
#undef PG8_LDA
#undef PG8_LDB
#undef PG8_MMA
#undef PG8_WAIT_V
#undef PG8_WAIT_L
#undef PG8_BAR
#undef PG8_SCHED
}
}
using pg8::Unit;

struct SchedMN {
    int nM, nN, nwg, G, c; const char* A; const char* B; size_t tstepA, tstepB;
    __device__ __forceinline__ void init(int M, int N, int G_, int c_, const void* A_, int lda, const void* B_, int ldb) {
        nM = M / 256; nN = N / 256; nwg = nM * nN; G = G_; c = c_; A = (const char*)A_; B = (const char*)B_; tstepA = (size_t)256 * lda * 2; tstepB = (size_t)256 * ldb * 2; }
    __device__ __forceinline__ bool next(int i, Unit& u) const {
        const long L = (long)i * G + c; if (L >= nwg) return false;
        int wgid = (int)L; { const int q = nwg / 8, r = nwg % 8, xcd = wgid % 8, off = wgid / 8; wgid = (xcd < r ? xcd * (q + 1) : r * (q + 1) + (xcd - r) * q) + off; }
        const int nig = 8 * nN, gid = wgid / nig, fm = gid * 8, gsz = (nM - fm) < 8 ? (nM - fm) : 8;
        u.pm = fm + ((wgid % nig) % gsz); u.pn = (wgid % nig) / gsz; u.z = 0; return true;
    }
    __device__ __forceinline__ const char* Aof(const Unit& u) const { return A + (size_t)u.pm * tstepA; }
    __device__ __forceinline__ const char* Bof(const Unit& u) const { return B + (size_t)u.pn * tstepB; }
};
struct SchedGrp {
    int nN, nwg, G, c; const char* A; const char* B; size_t zA, zB, tstepA, tstepB;
    __device__ __forceinline__ void init(int nN_, int G_, int c_, const void* A_, int lda, size_t zA_, const void* B_, int ldb, size_t zB_) {
        nN = nN_; nwg = 32 * 5 * nN_; G = G_; c = c_; A = (const char*)A_; B = (const char*)B_; zA = zA_; zB = zB_; tstepA = (size_t)256 * lda * 2; tstepB = (size_t)256 * ldb * 2; }
    __device__ __forceinline__ bool next(int i, Unit& u) const {
        const long L = (long)i * G + c; if (L >= nwg) return false;
        const int l = (int)L; u.z = l / (5 * nN); const int r = l % (5 * nN); u.pn = r / 5; u.pm = r % 5; return true;
    }
    __device__ __forceinline__ const char* Aof(const Unit& u) const { return A + (size_t)u.z * zA + (size_t)u.pm * tstepA; }
    __device__ __forceinline__ const char* Bof(const Unit& u) const { return B + (size_t)u.z * zB + (size_t)u.pn * tstepB; }
};
struct SchedBr {
    int G, c; const char* wsb;
    __device__ __forceinline__ bool next(int i, Unit& u) const {
        const long L = (long)(i >> 2) * G + c; if (L >= (MT / 256) * 4) return false;
        const int sub = i & 3, pnp = (int)L & 3; u.pm = (int)L >> 2; u.z = sub < 2 ? sub : 2; u.pn = sub == 3 ? pnp + 4 : pnp; return true;
    }
    __device__ __forceinline__ const char* Aof(const Unit& u) const { const size_t o = u.z == 0 ? (WS_BIG + BG_Q) : (u.z == 1 ? (WS_BIG + BG_QM) : WS_XN); return wsb + o + (size_t)u.pm * 256 * 512 * 2; }
    __device__ __forceinline__ const char* Bof(const Unit& u) const { const size_t o = u.z == 0 ? WS_WBA : (u.z == 1 ? WS_WBM : WS_WBG); return wsb + o + (size_t)u.pn * 256 * 512 * 2; }
};

typedef f32x4 AccT[2][2][4][2];
__device__ __forceinline__ u32x4 pack8(const f32x4 a, const f32x4 b) { u32x4 w; w.x = cvt_pk_bf16(a[0], a[1]); w.y = cvt_pk_bf16(a[2], a[3]); w.z = cvt_pk_bf16(b[0], b[1]); w.w = cvt_pk_bf16(b[2], b[3]); return w; }
__device__ __forceinline__ float siluf_(float x) { return x * sigmoidf_(x); }

struct EpiSwiglu {
    static constexpr bool PERM = true; bf16_t* O;
    __device__ __forceinline__ void operator()(const AccT& acc, const Unit& u, int wr, int wc, int fr, int fq) const {
        const int row0 = u.pm * 256 + wr * 64 + fr, col0 = u.pn * 128 + wc * 32 + 8 * fq;
#pragma unroll
        for (int ai = 0; ai < 2; ++ai)
#pragma unroll
            for (int m = 0; m < 4; ++m) {
                f32x4 v0, v1;
#pragma unroll
                for (int e = 0; e < 4; ++e) { v0[e] = siluf_(acc[ai][0][m][0][e]) * acc[ai][1][m][0][e]; v1[e] = siluf_(acc[ai][0][m][1][e]) * acc[ai][1][m][1][e]; }
                *(u32x4*)(O + (size_t)(row0 + ai * 128 + m * 16) * DFF + col0) = pack8(v0, v1);
            }
    }
};
struct EpiF32 {
    static constexpr bool PERM = false; float* C; int ldc;
    __device__ __forceinline__ void operator()(const AccT& acc, const Unit& u, int wr, int wc, int fr, int fq) const {
        const int row0 = u.pm * 256 + wr * 64 + fr, col0 = u.pn * 256 + wc * 32 + 4 * fq;
#pragma unroll
        for (int ai = 0; ai < 2; ++ai)
#pragma unroll
            for (int m = 0; m < 4; ++m) { float* rowp = C + (size_t)(row0 + ai * 128 + m * 16) * ldc + col0;
#pragma unroll
                for (int bj = 0; bj < 2; ++bj)
#pragma unroll
                    for (int n = 0; n < 2; ++n) *(f32x4*)(rowp + bj * 128 + n * 16) = acc[ai][bj][m][n]; }
    }
};
struct EpiMemKV {
    static constexpr bool PERM = false; float* outk; float* outv; bf16_t* MKV;
    __device__ __forceinline__ void operator()(const AccT& acc, const Unit& u, int wr, int wc, int fr, int fq) const {
        const int row0 = u.pm * 256 + wr * 64 + fr, col0 = u.pn * 256 + wc * 32 + 4 * fq;
#pragma unroll
        for (int ai = 0; ai < 2; ++ai)
#pragma unroll
            for (int m = 0; m < 4; ++m) { const int row = row0 + ai * 128 + m * 16;
#pragma unroll
                for (int bj = 0; bj < 2; ++bj)
#pragma unroll
                    for (int n = 0; n < 2; ++n) { const int col = col0 + bj * 128 + n * 16; const f32x4 v = acc[ai][bj][m][n];
                        float* o = (col < 512) ? outk + (size_t)row * 512 + col : outv + (size_t)row * 512 + (col - 512);
                        *(f32x4*)o = v; u32x2 w; w.x = cvt_pk_bf16(v[0], v[1]); w.y = cvt_pk_bf16(v[2], v[3]); *(u32x2*)(MKV + (size_t)row * 1024 + col) = w; } }
    }
};
struct EpiWin {
    static constexpr bool PERM = true; bf16_t *Q, *KK, *VV, *UG, *QM, *GATES; float* out;
    __device__ __forceinline__ void operator()(const AccT& acc, const Unit& u, int wr, int wc, int fr, int fq) const {
        const int pn = u.pn, row0 = u.pm * 256 + wr * 64 + fr, cw = wc * 32 + 8 * fq;
#pragma unroll
        for (int ai = 0; ai < 2; ++ai)
#pragma unroll
            for (int m = 0; m < 4; ++m) { const int row = row0 + ai * 128 + m * 16;
#pragma unroll
                for (int bj = 0; bj < 2; ++bj) { f32x4 v0 = acc[ai][bj][m][0], v1 = acc[ai][bj][m][1]; const int ct = bj * 128 + cw;
                    if (pn < 2) { v0 = v0 * QSCALE; v1 = v1 * QSCALE; *(u32x4*)(Q + (size_t)row * 512 + pn * 256 + ct) = pack8(v0, v1); }
                    else if (pn == 2) {
                        bf16_t* d = (bj == 0 ? KK : VV) + (size_t)row * 128 + cw; *(u32x4*)d = pack8(v0, v1);
                        float* o = nullptr;
                        if (row >= TP) o = out + (bj == 0 ? OUT_KS : OUT_VS) + (size_t)(row - TP) * 128 + cw;
                        else { const int pos = row & (SEQ - 1); if (pos >= SEQ - 128) o = out + (bj == 0 ? OUT_KP : OUT_VP) + (size_t)((row >> 14) * 128 + pos - (SEQ - 128)) * 128 + cw; }
                        if (o) { *(f32x4*)o = v0; *(f32x4*)(o + 4) = v1; }
                    }
                    else if (pn < 5) { const int cu = (pn - 3) * 256 + ct, g = cu >> 4, c0 = cu & 15;
                        *(u32x4*)(UG + ((size_t)g * NCHP + (row >> 5)) * UGW + (row & 31) * 16 + c0) = pack8(v0, v1); }
                    else if (pn < 7) { v0 = v0 * MSCALE; v1 = v1 * MSCALE; *(u32x4*)(QM + (size_t)row * 512 + (pn - 5) * 256 + ct) = pack8(v0, v1); }
                    else {
#pragma unroll
                        for (int e = 0; e < 4; ++e) { v0[e] = sigmoidf_(v0[e]); v1[e] = sigmoidf_(v1[e]); }
                        *(u32x4*)(GATES + (size_t)row * 3072 + (pn - 7) * 256 + ct) = pack8(v0, v1); }
                } }
    }
};
struct EpiLE {
    static constexpr bool PERM = false; float* LE;
    __device__ __forceinline__ void operator()(const AccT& acc, const Unit& u, int wr, int wc, int fr, int fq) const {
        const int row0 = u.pm * 256 + wr * 64 + fr, col0 = wc * 32 + 4 * fq;
#pragma unroll
        for (int ai = 0; ai < 2; ++ai)
#pragma unroll
            for (int m = 0; m < 4; ++m) { float* rowp = LE + ((size_t)u.z * NCHP + row0 + ai * 128 + m * 16) * 128 + col0;
#pragma unroll
                for (int n = 0; n < 2; ++n) *(f32x4*)(rowp + n * 16) = acc[ai][0][m][n]; }
    }
};
struct EpiY {
    static constexpr bool PERM = true; bf16_t* YB;
    __device__ __forceinline__ void operator()(const AccT& acc, const Unit& u, int wr, int wc, int fr, int fq) const {
        const int row0 = u.pm * 256 + wr * 64 + fr;
#pragma unroll
        for (int ai = 0; ai < 2; ++ai)
#pragma unroll
            for (int m = 0; m < 4; ++m) { const int chunk = row0 + ai * 128 + m * 16;
                if (chunk < NCH) {
#pragma unroll
                    for (int bj = 0; bj < 2; ++bj) { const int nc = u.pn * 256 + bj * 128 + wc * 32 + 8 * fq, i = nc >> 4, c0 = nc & 15;
                        *(u32x4*)(YB + ((size_t)chunk * 32 + i) * 512 + 16 * u.z + c0) = pack8(acc[ai][bj][m][0], acc[ai][bj][m][1]); } } }
    }
};
struct EpiBr {
    static constexpr bool PERM = true; const bf16_t* GATES; bf16_t* MG;
    __device__ __forceinline__ void operator()(const AccT& acc, const Unit& u, int wr, int wc, int fr, int fq) const {
        const int row0 = u.pm * 256 + wr * 64 + fr, cw = wc * 32 + 8 * fq;
#pragma unroll
        for (int ai = 0; ai < 2; ++ai)
#pragma unroll
            for (int m = 0; m < 4; ++m) { const int row = row0 + ai * 128 + m * 16;
                if (u.z < 2) {
#pragma unroll
                    for (int bj = 0; bj < 2; ++bj) { const int col = (u.pn + 4 * bj) * 128 + cw;
                        const u32x4 gw = *(const u32x4*)(GATES + (size_t)row * 3072 + (u.z == 0 ? 0 : 2048) + col);
                        bf16_t* mp = MG + (size_t)row * 1024 + col; f32x4 v0 = acc[ai][bj][m][0], v1 = acc[ai][bj][m][1];
                        v0[0] *= bf_lo(gw.x); v0[1] *= bf_hi(gw.x); v0[2] *= bf_lo(gw.y); v0[3] *= bf_hi(gw.y); v1[0] *= bf_lo(gw.z); v1[1] *= bf_hi(gw.z); v1[2] *= bf_lo(gw.w); v1[3] *= bf_hi(gw.w);
                        if (u.z == 1) { const u32x4 mw = *(const u32x4*)mp;
                            v0[0] += bf_lo(mw.x); v0[1] += bf_hi(mw.x); v0[2] += bf_lo(mw.y); v0[3] += bf_hi(mw.y); v1[0] += bf_lo(mw.z); v1[1] += bf_hi(mw.z); v1[2] += bf_lo(mw.w); v1[3] += bf_hi(mw.w); }
                        *(u32x4*)mp = pack8(v0, v1); }
                } else { const int col = u.pn * 128 + cw;
                    const u32x4 gw = *(const u32x4*)(GATES + (size_t)row * 3072 + 1024 + col);
                    bf16_t* mp = MG + (size_t)row * 1024 + col; const u32x4 mw = *(const u32x4*)mp; f32x4 v0, v1;
#pragma unroll
                    for (int e = 0; e < 4; ++e) { v0[e] = acc[ai][0][m][0][e] * sigmoidf_(acc[ai][1][m][0][e]); v1[e] = acc[ai][0][m][1][e] * sigmoidf_(acc[ai][1][m][1][e]); }
                    v0[0] = v0[0] * bf_lo(gw.x) + bf_lo(mw.x); v0[1] = v0[1] * bf_hi(gw.x) + bf_hi(mw.x); v0[2] = v0[2] * bf_lo(gw.y) + bf_lo(mw.y); v0[3] = v0[3] * bf_hi(gw.y) + bf_hi(mw.y);
                    v1[0] = v1[0] * bf_lo(gw.z) + bf_lo(mw.z); v1[1] = v1[1] * bf_hi(gw.z) + bf_hi(mw.z); v1[2] = v1[2] * bf_lo(gw.w) + bf_lo(mw.w); v1[3] = v1[3] * bf_hi(gw.w) + bf_hi(mw.w);
                    *(u32x4*)mp = pack8(v0, v1); }
            }
    }
};

__device__ __forceinline__ void tr_item(const float* W, int N, int k0, int n0, const float* gain, bf16_t* WT, int ldw, int dst_row0, LAS float* scr, int lane) {
#pragma unroll 8
    for (int i = 0; i < 32; ++i) { const int kk = 2 * i + (lane >> 5); float v = W[(size_t)(k0 + kk) * N + n0 + (lane & 31)]; if (gain) v *= gain[k0 + kk]; scr[kk * 33 + (lane & 31)] = v; }
    LDS_WAIT(); asm volatile("" ::: "memory");
    const int c = lane & 7;
#pragma unroll
    for (int j = 0; j < 4; ++j) { const int n = (lane >> 3) + 8 * j; const LAS float* s = scr + (8 * c) * 33 + n;
        u32x4 o; o.x = cvt_pk_bf16(s[0 * 33], s[1 * 33]); o.y = cvt_pk_bf16(s[2 * 33], s[3 * 33]); o.z = cvt_pk_bf16(s[4 * 33], s[5 * 33]); o.w = cvt_pk_bf16(s[6 * 33], s[7 * 33]);
        *(u32x4*)(WT + (size_t)(dst_row0 + n) * ldw + k0 + 8 * c) = o; }
    LDS_WAIT(); asm volatile("" ::: "memory");
}
__device__ __forceinline__ void rms_row_to_bf16(const float* xrow, bf16_t* orow, int lane) {
    const f32x4* xr = (const f32x4*)xrow + lane; f32x4 v[4]; float s = 0.f;
#pragma unroll
    for (int j = 0; j < 4; ++j) { v[j] = xr[64 * j]; s += (v[j][0] * v[j][0] + v[j][1] * v[j][1]) + (v[j][2] * v[j][2] + v[j][3] * v[j][3]); }
    const float rstd = 1.0f / sqrtf(wave_sum(s) * (1.0f / DM) + RMS_EPS);
    u32x2* o8 = (u32x2*)orow + lane;
#pragma unroll
    for (int j = 0; j < 4; ++j) { u32x2 w; w.x = cvt_pk_bf16(v[j][0] * rstd, v[j][1] * rstd); w.y = cvt_pk_bf16(v[j][2] * rstd, v[j][3] * rstd); o8[64 * j] = w; }
}
__device__ __forceinline__ void resid_row(const float* orow, const float* xin, const float* gpost, float f, float* xo, bf16_t* xn, int lane) {
    const f32x4* orr = (const f32x4*)orow + lane; const f32x4* xr = (const f32x4*)xin + lane; const f32x4* gr = (const f32x4*)gpost + lane;
    f32x4 o[4], x[4]; float s = 0.f;
#pragma unroll
    for (int j = 0; j < 4; ++j) { o[j] = orr[64 * j]; x[j] = xr[64 * j]; s += (o[j][0] * o[j][0] + o[j][1] * o[j][1]) + (o[j][2] * o[j][2] + o[j][3] * o[j][3]); }
    const float rstd = f / sqrtf(wave_sum(s) * (1.0f / DM) + RMS_EPS); float s2 = 0.f;
#pragma unroll
    for (int j = 0; j < 4; ++j) { const f32x4 g = gr[64 * j]; x[j] = x[j] + o[j] * g * rstd; s2 += (x[j][0] * x[j][0] + x[j][1] * x[j][1]) + (x[j][2] * x[j][2] + x[j][3] * x[j][3]); }
    f32x4* xw = (f32x4*)xo + lane;
#pragma unroll
    for (int j = 0; j < 4; ++j) xw[64 * j] = x[j];
    if (xn) { const float r2 = 1.0f / sqrtf(wave_sum(s2) * (1.0f / DM) + RMS_EPS); u32x2* o8 = (u32x2*)xn + lane;
#pragma unroll
        for (int j = 0; j < 4; ++j) { u32x2 w; w.x = cvt_pk_bf16(x[j][0] * r2, x[j][1] * r2); w.y = cvt_pk_bf16(x[j][2] * r2, x[j][3] * r2); o8[64 * j] = w; } }
}
__device__ __forceinline__ void sincos_d(double a, float& s, float& c) {
    const double k = __builtin_rint(a * 0.63661977236758134308);
    const double r = (a - k * 1.57079632679489655800) - k * 6.12323399573676603587e-17;
    const double r2 = r * r;
    const double sp = r * (1.0 + r2 * (-1.0 / 6 + r2 * (1.0 / 120 + r2 * (-1.0 / 5040 + r2 * (1.0 / 362880 + r2 * (-1.0 / 39916800))))));
    const double cp = 1.0 + r2 * (-0.5 + r2 * (1.0 / 24 + r2 * (-1.0 / 720 + r2 * (1.0 / 40320 + r2 * (-1.0 / 3628800 + r2 * (1.0 / 479001600))))));
    const int q = (int)((long long)k & 3);
    const double ss = (q == 0) ? sp : (q == 1) ? cp : (q == 2) ? -sp : -cp;
    const double cc = (q == 0) ? cp : (q == 1) ? -sp : (q == 2) ? -cp : sp;
    s = (float)ss; c = (float)cc;
}
__device__ __forceinline__ void ssm_small_tables(int g, int d, int lane, const float* lam_re, const float* lam_im, const float* log_dt, const float* b_re, const float* b_im,
                                                 const float* c_re, const float* c_im, const float* dskip, float* POW, float* BBAR, float* KTAB) {
    const int p = lane;
    const double dt = (double)expf(log_dt[g]);
    const double lr = (double)lam_re[g * 64 + p], li = (double)lam_im[g * 64 + p];
    float s1, c1; sincos_d(li * dt, s1, c1);
    const float mag1 = expf((float)(lr * dt));
    const float a_re = mag1 * c1, a_im = mag1 * s1;
    const float lrf = (float)lr, lif = (float)li, den = lrf * lrf + lif * lif;
    const float coef_re = ((a_re - 1.0f) * lrf + a_im * lif) / den, coef_im = (a_im * lrf - (a_re - 1.0f) * lif) / den;
    float sd, cd; sincos_d(li * dt * (double)d, sd, cd);
    const float magd = expf((float)(lr * dt * (double)d));
    const float pd_re = magd * cd, pd_im = magd * sd;
    POW[((size_t)(g * 64 + p) * 33 + d) * 2 + 0] = pd_re; POW[((size_t)(g * 64 + p) * 33 + d) * 2 + 1] = pd_im;
    float er[16], ei[16];
#pragma unroll
    for (int cc = 0; cc < 16; ++cc) { const float br = b_re[(size_t)(g * 64 + p) * 16 + cc], bi = b_im[(size_t)(g * 64 + p) * 16 + cc];
        const float bbr = coef_re * br - coef_im * bi, bbi = coef_re * bi + coef_im * br;
        if (d == 0) { BBAR[((size_t)(g * 64 + p) * 16 + cc) * 2 + 0] = bbr; BBAR[((size_t)(g * 64 + p) * 16 + cc) * 2 + 1] = bbi; }
        er[cc] = pd_re * bbr - pd_im * bbi; ei[cc] = pd_re * bbi + pd_im * bbr; }
    if (d >= 32) return;
    float keep = 0.f;
#pragma unroll 1
    for (int c = 0; c < 16; ++c) { const float cr = c_re[(size_t)(g * 16 + c) * 64 + p], ci = c_im[(size_t)(g * 16 + c) * 64 + p];
#pragma unroll
        for (int cc = 0; cc < 16; ++cc) { float t = wave_sum(cr * er[cc] - ci * ei[cc]); if (d == 0 && c == cc) t += dskip[g * 16 + c];
            if ((((c & 3) << 4) | cc) == lane) keep = t; }
        if ((c & 3) == 3) KTAB[((size_t)(g * 32 + d) * 256) + (c >> 2) * 64 + lane] = keep; }
}
__device__ __forceinline__ void ssm_expand_tables(size_t gtid, size_t gsz, const float* POW, const float* BBAR, const float* KTAB, const float* c_re, const float* c_im, bf16_t* TG, bf16_t* MG) {
    for (size_t it = gtid; it < (size_t)32 * 512 * 80; it += gsz) {
        const int k0 = (int)(it % 80) * 8, n = (int)((it / 80) % 512), g = (int)(it / (80 * 512)), i = n >> 4, c = n & 15; float v[8];
        if (k0 < 512) { const int j = k0 >> 4, c0 = k0 & 15;
#pragma unroll
            for (int e = 0; e < 8; ++e) v[e] = (j <= i) ? KTAB[((size_t)(g * 32 + (i - j)) * 256) + c * 16 + c0 + e] : 0.f;
        } else { const int p0 = (k0 - 512) & 63; const bool im = k0 >= 576;
#pragma unroll
            for (int e = 0; e < 8; ++e) { const int p = p0 + e; const float cr = c_re[(size_t)(g * 16 + c) * 64 + p], ci = c_im[(size_t)(g * 16 + c) * 64 + p];
                const float pr = POW[((size_t)(g * 64 + p) * 33 + i + 1) * 2], pi = POW[((size_t)(g * 64 + p) * 33 + i + 1) * 2 + 1];
                v[e] = im ? -(cr * pi + ci * pr) : (cr * pr - ci * pi); } }
        u32x4 w; w.x = cvt_pk_bf16(v[0], v[1]); w.y = cvt_pk_bf16(v[2], v[3]); w.z = cvt_pk_bf16(v[4], v[5]); w.w = cvt_pk_bf16(v[6], v[7]);
        *(u32x4*)(TG + ((size_t)g * 512 + n) * UGW + k0) = w;
    }
    for (size_t it = gtid; it < (size_t)32 * 256 * 64; it += gsz) {
        const int k0 = (int)(it % 64) * 8, n = (int)((it / 64) % 256), g = (int)(it / (64 * 256)); float v[8];
        if (n < 128) { const int p = n & 63, j = k0 >> 4, c0 = k0 & 15; const bool im = n >= 64;
            const float pr = POW[((size_t)(g * 64 + p) * 33 + (31 - j)) * 2], pi = POW[((size_t)(g * 64 + p) * 33 + (31 - j)) * 2 + 1];
#pragma unroll
            for (int e = 0; e < 8; ++e) { const float br = BBAR[((size_t)(g * 64 + p) * 16 + c0 + e) * 2], bi = BBAR[((size_t)(g * 64 + p) * 16 + c0 + e) * 2 + 1];
                v[e] = im ? (pr * bi + pi * br) : (pr * br - pi * bi); }
        } else {
#pragma unroll
            for (int e = 0; e < 8; ++e) v[e] = 0.f; }
        u32x4 w; w.x = cvt_pk_bf16(v[0], v[1]); w.y = cvt_pk_bf16(v[2], v[3]); w.z = cvt_pk_bf16(v[4], v[5]); w.w = cvt_pk_bf16(v[6], v[7]);
        *(u32x4*)(MG + ((size_t)g * 256 + n) * 512 + k0) = w;
    }
}
__device__ __forceinline__ void ssm_carry_prompt(int idx  , const float* POW, const float* LE, bf16_t* UG, float* out) {
    const int p = idx & 63, g = (idx >> 6) & 31, b = idx >> 11;
    const float ar = POW[((size_t)(g * 64 + p) * 33 + 32) * 2], ai = POW[((size_t)(g * 64 + p) * 33 + 32) * 2 + 1];
    float sr = 0.f, si = 0.f;
    const float* le = LE + ((size_t)g * NCHP + b * 512) * 128 + p; bf16_t* ug = UG + ((size_t)g * NCHP + b * 512) * UGW + 512 + p;
#pragma unroll 1
    for (int c0 = 0; c0 < 512; c0 += 16) {
        float lr[16], li[16];
#pragma unroll
        for (int j = 0; j < 16; ++j) { lr[j] = le[(size_t)(c0 + j) * 128]; li[j] = le[(size_t)(c0 + j) * 128 + 64]; }
#pragma unroll
        for (int j = 0; j < 16; ++j) { const unsigned w = cvt_pk_bf16(sr, si); ug[(size_t)(c0 + j) * UGW] = (bf16_t)(w & 0xffffu); ug[(size_t)(c0 + j) * UGW + 64] = (bf16_t)(w >> 16);
            const float nr = ar * sr - ai * si + lr[j], ni = ar * si + ai * sr + li[j]; sr = nr; si = ni; }
    }
    out[OUT_SRP + (size_t)(b * 32 + g) * 64 + p] = sr; out[OUT_SIP + (size_t)(b * 32 + g) * 64 + p] = si;
}
__device__ __forceinline__ void ssm_carry_sample(int idx  , const float* POW, const float* LE, bf16_t* UG, const float* s0r, const float* s0i, float* out) {
    const int p = idx & 63, g = (idx >> 6) & 31, db = idx >> 11;
    const float ar = POW[((size_t)(g * 64 + p) * 33 + 32) * 2], ai = POW[((size_t)(g * 64 + p) * 33 + 32) * 2 + 1];
    const float sr = s0r[(size_t)(db * 32 + g) * 64 + p], si = s0i[(size_t)(db * 32 + g) * 64 + p];
    bf16_t* ug = UG + ((size_t)g * NCHP + 1024 + db) * UGW + 512 + p; const unsigned w = cvt_pk_bf16(sr, si); ug[0] = (bf16_t)(w & 0xffffu); ug[64] = (bf16_t)(w >> 16);
    const float* le = LE + ((size_t)g * NCHP + 1024 + db) * 128 + p;
    out[OUT_SRS + (size_t)(db * 32 + g) * 64 + p] = ar * sr - ai * si + le[0]; out[OUT_SIS + (size_t)(db * 32 + g) * 64 + p] = ar * si + ai * sr + le[64];
}

template <int HD, int NT>
__device__ __forceinline__ void att_scores(f32x16 (&S)[NT], const LAS unsigned char* Kl, const int kpitch, const bf16x8 (&qf)[HD / 16], int r32, int hi) {
#pragma unroll
    for (int t = 0; t < NT; ++t) {
        f32x16 acc = {};
#pragma unroll
        for (int s = 0; s < HD / 16; ++s) {
            const bf16x8 a = *(const LAS bf16x8*)(Kl + (t * 32 + r32) * kpitch + (16 * s + 8 * hi) * 2);
            acc = __builtin_amdgcn_mfma_f32_32x32x16_bf16(a, qf[s], acc, 0, 0, 0);
        }
        S[t] = acc;
    }
}
template <int HD, int NT>
__device__ __forceinline__ void att_pv(f32x16 (&O)[HD / 32], const LAS unsigned char* Vt, const int vpitch, const f32x16 (&P)[NT], int r32, int hi) {
#pragma unroll
    for (int t = 0; t < NT; ++t)
#pragma unroll
        for (int s2 = 0; s2 < 2; ++s2) {
            u32x4 pw; pw.x = cvt_pk_bf16(P[t][8 * s2 + 0], P[t][8 * s2 + 1]); pw.y = cvt_pk_bf16(P[t][8 * s2 + 2], P[t][8 * s2 + 3]);
            pw.z = cvt_pk_bf16(P[t][8 * s2 + 4], P[t][8 * s2 + 5]); pw.w = cvt_pk_bf16(P[t][8 * s2 + 6], P[t][8 * s2 + 7]);
            const bf16x8 pf = __builtin_bit_cast(bf16x8, pw);
            const int ks = 2 * t + s2;
#pragma unroll
            for (int dt = 0; dt < HD / 32; ++dt) {
                const LAS unsigned char* vp = Vt + (dt * 32 + r32) * vpitch + (16 * ks + 4 * hi) * 2;
                const s16x4 lo = *(const LAS s16x4*)vp, h4 = *(const LAS s16x4*)(vp + 16);
                const bf16x8 vf = {lo[0], lo[1], lo[2], lo[3], h4[0], h4[1], h4[2], h4[3]};
                O[dt] = __builtin_amdgcn_mfma_f32_32x32x16_bf16(vf, pf, O[dt], 0, 0, 0);
            }
        }
}
template <int HD, class Src>
__device__ __forceinline__ void att_fill(LAS unsigned char* Kl, int kpitch, LAS unsigned char* Vt, int vpitch, int nkeys, const Src& src, int tid, int nthr) {
    constexpr int CH = HD / 8;
    for (int it = tid; it < nkeys * CH; it += nthr) {
        const int key = it / CH, d0 = (it % CH) * 8;
        const u32x4 kw = src.k8(key, d0); *(LAS u32x4*)(Kl + key * kpitch + d0 * 2) = kw;
        const u32x4 vw = src.v8(key, d0); LAS unsigned char* vp = Vt + d0 * vpitch + key * 2;
        *(LAS bf16_t*)(vp + 0 * vpitch) = (bf16_t)(vw.x & 0xffffu); *(LAS bf16_t*)(vp + 1 * vpitch) = (bf16_t)(vw.x >> 16);
        *(LAS bf16_t*)(vp + 2 * vpitch) = (bf16_t)(vw.y & 0xffffu); *(LAS bf16_t*)(vp + 3 * vpitch) = (bf16_t)(vw.y >> 16);
        *(LAS bf16_t*)(vp + 4 * vpitch) = (bf16_t)(vw.z & 0xffffu); *(LAS bf16_t*)(vp + 5 * vpitch) = (bf16_t)(vw.z >> 16);
        *(LAS bf16_t*)(vp + 6 * vpitch) = (bf16_t)(vw.w & 0xffffu); *(LAS bf16_t*)(vp + 7 * vpitch) = (bf16_t)(vw.w >> 16);
    }
}
__device__ __forceinline__ u32x4 ld8_bf16(const bf16_t* p) { return *(const u32x4*)p; }
__device__ __forceinline__ u32x4 ld8_f32(const float* p) { const f32x4 a = *(const f32x4*)p, b = *(const f32x4*)(p + 4); u32x4 w; w.x = cvt_pk_bf16(a[0], a[1]); w.y = cvt_pk_bf16(a[2], a[3]); w.z = cvt_pk_bf16(b[0], b[1]); w.w = cvt_pk_bf16(b[2], b[3]); return w; }

template <int NT>
__device__ __forceinline__ void swa_wave(const bf16_t* qrow, bf16_t* orow, const LAS unsigned char* Kl, const LAS unsigned char* Vt, const int vpitch, const LAS float* biasL, const float sinkl,
                                         const int i, const int jmin, const int r32, const int hi) {
    bf16x8 qf[4];
#pragma unroll
    for (int s = 0; s < 4; ++s) qf[s] = *(const bf16x8*)(qrow + 16 * s + 8 * hi);
    f32x16 S[NT]; att_scores<64, NT>(S, Kl, 144, qf, r32, hi);
    float m = sinkl;
#pragma unroll
    for (int t = 0; t < NT; ++t)
#pragma unroll
        for (int r = 0; r < 16; ++r) { const int j = 32 * t + (r & 3) + 8 * (r >> 2) + 4 * hi; float v = S[t][r] + biasL[j - i + 63]; v = (j < jmin) ? -1e30f : v; S[t][r] = v; m = fmaxf(m, v); }
    m = fmaxf(m, __shfl_xor(m, 32));
    float l = 0.f;
#pragma unroll
    for (int t = 0; t < NT; ++t)
#pragma unroll
        for (int r = 0; r < 16; ++r) { const float p = fast_exp2(S[t][r] - m); S[t][r] = p; l += p; }
    l += __shfl_xor(l, 32); l += fast_exp2(sinkl - m);
    f32x16 O[2]; O[0] = f32x16{}; O[1] = f32x16{};
    att_pv<64, NT>(O, Vt, vpitch, S, r32, hi);
    const float inv = 1.0f / l;
#pragma unroll
    for (int dt = 0; dt < 2; ++dt)
#pragma unroll
        for (int rq = 0; rq < 4; ++rq) { u32x2 w; w.x = cvt_pk_bf16(O[dt][4 * rq] * inv, O[dt][4 * rq + 1] * inv); w.y = cvt_pk_bf16(O[dt][4 * rq + 2] * inv, O[dt][4 * rq + 3] * inv);
            *(u32x2*)(orow + dt * 32 + 8 * rq + 4 * hi) = w; }
}

struct SrcSwaPrompt { const bf16_t* KK; const bf16_t* VV; int b, c, g;
    __device__ __forceinline__ u32x4 k8(int key, int d0) const { const int pos = c * 64 - 128 + key; if (pos < 0) return (u32x4){0u, 0u, 0u, 0u}; return ld8_bf16(KK + ((size_t)b * SEQ + pos) * 128 + g * 64 + d0); }
    __device__ __forceinline__ u32x4 v8(int key, int d0) const { const int pos = c * 64 - 128 + key; if (pos < 0) return (u32x4){0u, 0u, 0u, 0u}; return ld8_bf16(VV + ((size_t)b * SEQ + pos) * 128 + g * 64 + d0); } };
struct SrcSwaSample { const bf16_t* KK; const bf16_t* VV; const float* ck; const float* cv; int db, g;
    __device__ __forceinline__ u32x4 k8(int key, int d0) const { if (key < 128) return ld8_f32(ck + (((size_t)db * 128 + key) * 2 + g) * 64 + d0); return ld8_bf16(KK + ((size_t)TP + db * 32 + key - 128) * 128 + g * 64 + d0); }
    __device__ __forceinline__ u32x4 v8(int key, int d0) const { if (key < 128) return ld8_f32(cv + (((size_t)db * 128 + key) * 2 + g) * 64 + d0); return ld8_bf16(VV + ((size_t)TP + db * 32 + key - 128) * 128 + g * 64 + d0); } };
struct SrcCrossPrompt { const bf16_t* MKV; int b, h, kb;
    __device__ __forceinline__ u32x4 k8(int key, int d0) const { return ld8_bf16(MKV + ((size_t)b * 256 + kb + key) * 1024 + h * 128 + d0); }
    __device__ __forceinline__ u32x4 v8(int key, int d0) const { return ld8_bf16(MKV + ((size_t)b * 256 + kb + key) * 1024 + 512 + h * 128 + d0); } };
struct SrcCrossSample { const float* ck; const float* cv; int db, h, kb;
    __device__ __forceinline__ u32x4 k8(int key, int d0) const { return ld8_f32(ck + (((size_t)db * 256 + kb + key) * 4 + h) * 128 + d0); }
    __device__ __forceinline__ u32x4 v8(int key, int d0) const { return ld8_f32(cv + (((size_t)db * 256 + kb + key) * 4 + h) * 128 + d0); } };

__device__ __forceinline__ void swa_prompt_unit(int unit, LAS unsigned char* lds, bf16_t* Q, const bf16_t* KK, const bf16_t* VV, const float* BIAS, int tid, int wave, int lane) {
    const int g = unit & 1, c = (unit >> 1) & 255, b = unit >> 9;
    LAS unsigned char* Kl = lds; LAS unsigned char* Vt = lds + 192 * 144; LAS float* bl = (LAS float*)(lds + 192 * 144 + 64 * 392);
    for (int it = tid; it < 1024; it += NTHREADS) bl[it] = BIAS[(4 * g + (it >> 8)) * 256 + (it & 255)];
    SrcSwaPrompt src{KK, VV, b, c, g};
    att_fill<64>(Kl, 144, Vt, 392, 192, src, tid, NTHREADS);
    __syncthreads();
    const int r32 = lane & 31, hi = lane >> 5, r = wave >> 1, i = 32 * (wave & 1) + r32;
    bf16_t* qrow = Q + ((size_t)b * SEQ + c * 64 + i) * 512 + g * 256 + r * 64;
    const int jmin = 128 - 64 * c;
    swa_wave<6>(qrow, qrow, Kl, Vt, 392, bl + r * 256, BIAS[8 * 256 + 4 * g + r], i, jmin, r32, hi);
}
__device__ __forceinline__ void swa_sample_unit(int db, LAS unsigned char* lds, bf16_t* Q, const bf16_t* KK, const bf16_t* VV, const float* ck, const float* cv, const float* BIAS, int tid, int wave, int lane) {
    LAS float* bl = (LAS float*)(lds + 2 * 160 * 144 + 2 * 64 * 328);
    for (int it = tid; it < 2048; it += NTHREADS) bl[it] = BIAS[it];
#pragma unroll 1
    for (int g = 0; g < 2; ++g) { SrcSwaSample src{KK, VV, ck, cv, db, g}; att_fill<64>(lds + g * 160 * 144, 144, lds + 2 * 160 * 144 + g * 64 * 328, 328, 160, src, tid, NTHREADS); }
    __syncthreads();
    const int r32 = lane & 31, hi = lane >> 5, g = wave >> 2, r = wave & 3;
    bf16_t* qrow = Q + ((size_t)TP + db * 32 + r32) * 512 + g * 256 + r * 64;
    swa_wave<5>(qrow, qrow, lds + g * 160 * 144, lds + 2 * 160 * 144 + g * 64 * 328, 328, bl + (4 * g + r) * 256, BIAS[8 * 256 + 4 * g + r], r32, 0, r32, hi);
}
template <class Src>
__device__ __forceinline__ void cross_unit(Src src, const bool active, bf16_t* qrow, LAS unsigned char* lds, int tid, int lane) {
    const int r32 = lane & 31, hi = lane >> 5;
    LAS unsigned char* Kl = lds; LAS unsigned char* Vt = lds + 128 * 272;
    bf16x8 qf[8];
    if (active) {
#pragma unroll
        for (int s = 0; s < 8; ++s) qf[s] = *(const bf16x8*)(qrow + 16 * s + 8 * hi);
    } else {
#pragma unroll
        for (int s = 0; s < 8; ++s) qf[s] = bf16x8{};
    }
    float m = -1e30f, l = 0.f; f32x16 O[4];
#pragma unroll
    for (int d = 0; d < 4; ++d) O[d] = f32x16{};
#pragma unroll 1
    for (int kb = 0; kb < 256; kb += 128) {
        src.kb = kb;
        if (kb) __syncthreads();
        att_fill<128>(Kl, 272, Vt, 264, 128, src, tid, NTHREADS);
        __syncthreads();
        if (active) {
            f32x16 S[4]; att_scores<128, 4>(S, Kl, 272, qf, r32, hi);
            float mb = m;
#pragma unroll
            for (int t = 0; t < 4; ++t)
#pragma unroll
                for (int r = 0; r < 16; ++r) mb = fmaxf(mb, S[t][r]);
            mb = fmaxf(mb, __shfl_xor(mb, 32));
            const float alpha = fast_exp2(m - mb); m = mb; float ls = 0.f;
#pragma unroll
            for (int t = 0; t < 4; ++t)
#pragma unroll
                for (int r = 0; r < 16; ++r) { const float p = fast_exp2(S[t][r] - m); S[t][r] = p; ls += p; }
            ls += __shfl_xor(ls, 32); l = l * alpha + ls;
#pragma unroll
            for (int d = 0; d < 4; ++d) O[d] = O[d] * alpha;
            att_pv<128, 4>(O, Vt, 264, S, r32, hi);
        }
    }
    if (active) { const float inv = 1.0f / l;
#pragma unroll
        for (int dt = 0; dt < 4; ++dt)
#pragma unroll
            for (int rq = 0; rq < 4; ++rq) { u32x2 w; w.x = cvt_pk_bf16(O[dt][4 * rq] * inv, O[dt][4 * rq + 1] * inv); w.y = cvt_pk_bf16(O[dt][4 * rq + 2] * inv, O[dt][4 * rq + 3] * inv);
                *(u32x2*)(qrow + dt * 32 + 8 * rq + 4 * hi) = w; } }
}

#define XB_TMO      128
#define XB_XCNT(j)  (256  + 64 * (j))
#define XB_XSUB(j)  (1280 + 64 * (j))
#define XB_XGEN(j)  (2304 + 64 * (j))
#define XB_TOP      3328
#define XB_TOPGEN   3392
#define XCD_BAR_WORDS 3456
#define XB_SPIN_CAP (1u << 18)

__device__ __forceinline__ unsigned xb_ld(unsigned* p)              { return __hip_atomic_load(p, __ATOMIC_RELAXED, __HIP_MEMORY_SCOPE_AGENT); }
__device__ __forceinline__ unsigned xb_add(unsigned* p, unsigned v) { return __hip_atomic_fetch_add(p, v, __ATOMIC_RELAXED, __HIP_MEMORY_SCOPE_AGENT); }
__device__ __forceinline__ unsigned xb_xcc_id() { return (unsigned)__builtin_amdgcn_s_getreg((3 << 11) | 20) & 0xFu; }
#define XB_SPIN(cond, bar) do { unsigned _sp = 0; while (cond) { __builtin_amdgcn_s_sleep(1); \
    if ((++_sp & 255u) == 0u) { if (xb_ld(&(bar)[XB_TMO])) break; if (_sp > XB_SPIN_CAP) { atomicAdd(&(bar)[XB_TMO], 1u); break; } } } } while (0)

struct XcdBarrier {
    unsigned* bar; unsigned x;
    volatile LAS unsigned* st;
};

__device__ __forceinline__ XcdBarrier xcd_barrier_post(unsigned* bar, volatile LAS unsigned* st) {
    XcdBarrier b; b.bar = bar; b.x = xb_xcc_id(); b.st = st;
    if (threadIdx.x == 0) (void)xb_add(&bar[XB_XCNT(b.x)], 1u);
    return b;
}
__device__ __forceinline__ void xcd_barrier_complete(unsigned* bar, unsigned x, unsigned& nloc, unsigned& nx) {
    const unsigned G = gridDim.x * gridDim.y * gridDim.z;
    unsigned sum, cnt, mine, sp = 0u;
    for (;;) {
        sum = 0u; cnt = 0u; mine = 0u;
#pragma unroll
        for (unsigned j = 0; j < 16; ++j) { const unsigned c = xb_ld(&bar[XB_XCNT(j)]); sum += c; cnt += (c > 0u) ? 1u : 0u; mine = (j == x) ? c : mine; }
        if (sum == G) break;
        __builtin_amdgcn_s_sleep(1);
        if ((++sp & 255u) == 0u) { if (xb_ld(&bar[XB_TMO])) break; if (sp > XB_SPIN_CAP) { atomicAdd(&bar[XB_TMO], 1u); break; } }
    }
    nloc = mine > 0u ? mine : 1u; nx = cnt > 0u ? cnt : 1u;
}

__device__ __forceinline__ void xcd_barrier(const XcdBarrier& b) {
    asm volatile("s_waitcnt vmcnt(0)" ::: "memory");
    __syncthreads();
    if (threadIdx.x == 0) {
        unsigned* bar = b.bar;
        __builtin_amdgcn_s_waitcnt(0);
        unsigned nloc = b.st[0], nx = b.st[1];
        if (nloc == 0u) { xcd_barrier_complete(bar, b.x, nloc, nx); b.st[0] = nloc; b.st[1] = nx; }
        const unsigned old = xb_add(&bar[XB_XSUB(b.x)], 1u);
        const unsigned gen = old / nloc;
        if (old + 1u == (gen + 1u) * nloc) {
            __builtin_amdgcn_fence(__ATOMIC_RELEASE, "agent");
            asm volatile("s_waitcnt vmcnt(0)" ::: "memory");
            const unsigned og = xb_add(&bar[XB_TOP], 1u);
            const unsigned tg = og / nx;
            if (og + 1u == (tg + 1u) * nx) xb_add(&bar[XB_TOPGEN], 1u);
            else XB_SPIN(xb_ld(&bar[XB_TOPGEN]) == tg, bar);
            __builtin_amdgcn_fence(__ATOMIC_ACQUIRE, "agent");
            xb_add(&bar[XB_XGEN(b.x)], 1u);
            asm volatile("s_waitcnt vmcnt(0)" ::: "memory");
        } else {
            XB_SPIN(xb_ld(&bar[XB_XGEN(b.x)]) == gen, bar);
            __builtin_amdgcn_fence(__ATOMIC_ACQUIRE, "agent");
            asm volatile("s_waitcnt vmcnt(0)" ::: "memory");
        }
    }
    __syncthreads();
}

constexpr int CW_BAR = 4096;
struct Args { const float* in[36]; float* out; unsigned char* ws; };

__device__ __forceinline__ int queue_next(unsigned* ctr, volatile LAS unsigned* slot, int tid) {
    __syncthreads();
    if (tid == 0) *slot = atomicAdd(ctr, 1u);
    __syncthreads();
    return (int)*slot;
}

__global__ void __launch_bounds__(NTHREADS, 2) fwd_megakernel(Args a_unused) {
    extern __shared__ __attribute__((aligned(16))) unsigned char lds_raw[];
    LAS unsigned char* lds = (LAS unsigned char*)lds_raw;
    volatile LAS unsigned* MISC = (volatile LAS unsigned*)(lds + MISC_OFF);
    cg::grid_group grid = cg::this_grid();
#define CAS __attribute__((address_space(4)))
#define GAS __attribute__((address_space(1)))
#define ARGP(k) ((const float*)(const GAS float*)(*(const CAS unsigned long long*)(kp + 8 * (k))))
#define PHASE_PTRS() const CAS char* kp = (const CAS char*)__builtin_amdgcn_kernarg_segment_ptr(); asm volatile("" : "+s"(kp)); \
    float* out = (float*)ARGP(36); unsigned char* ws = (unsigned char*)ARGP(37); \
    unsigned* ctl = (unsigned*)(ws + WS_CTL); (void)ctl; \
    bf16_t *W1A = (bf16_t*)(ws + WS_W1A), *W1B = (bf16_t*)(ws + WS_W1B), *W2A = (bf16_t*)(ws + WS_W2A), *W2B = (bf16_t*)(ws + WS_W2B), *WIN = (bf16_t*)(ws + WS_WIN), *WBA = (bf16_t*)(ws + WS_WBA), \
           *WBM = (bf16_t*)(ws + WS_WBM), *WBG = (bf16_t*)(ws + WS_WBG), *WOUT = (bf16_t*)(ws + WS_WOUT), *WMKV = (bf16_t*)(ws + WS_WMKV), *TG = (bf16_t*)(ws + WS_TG), *MGT = (bf16_t*)(ws + WS_MG), \
           *MEMN = (bf16_t*)(ws + WS_MEMN), *MKV = (bf16_t*)(ws + WS_MKV), *XN = (bf16_t*)(ws + WS_XN), *YB = (bf16_t*)(ws + WS_XN); \
    unsigned char* big = ws + WS_BIG; \
    bf16_t *UG = (bf16_t*)(big + BG_UG), *KK = (bf16_t*)(big + BG_KK), *VV = (bf16_t*)(big + BG_VV), *Q = (bf16_t*)(big + BG_Q), *QM = (bf16_t*)(big + BG_QM), *GATES = (bf16_t*)(big + BG_GATES), \
           *MERGED = (bf16_t*)(big + BG_MERGED), *ACT = (bf16_t*)(big + BG_ACT); \
    float *LE = (float*)(big + BG_LE), *OB = (float*)(big + BG_O); \
    float *POW = (float*)(ws + WS_TAB + TAB_POW), *BBAR = (float*)(ws + WS_TAB + TAB_BBAR), *KTAB = (float*)(ws + WS_TAB + TAB_KTAB), *BIAS = (float*)(ws + WS_TAB + TAB_BIAS); \
    (void)W1A; (void)W1B; (void)W2A; (void)W2B; (void)WIN; (void)WBA; (void)WBM; (void)WBG; (void)WOUT; (void)WMKV; (void)TG; (void)MGT; (void)MEMN; (void)MKV; (void)XN; (void)YB; (void)UG; (void)KK; (void)VV; \
    (void)Q; (void)QM; (void)GATES; (void)MERGED; (void)ACT; (void)LE; (void)OB; (void)POW; (void)BBAR; (void)KTAB; (void)BIAS; (void)out; \
    int tid_ = threadIdx.x; asm volatile("" : "+v"(tid_)); const int tid = tid_, lane = tid & 63, wave = __builtin_amdgcn_readfirstlane(tid >> 6); (void)lane; (void)wave; \
    int bx_ = blockIdx.x, G_ = gridDim.x; asm volatile("" : "+s"(bx_), "+s"(G_)); const int G = G_, bx = bx_, gw = bx * NWAVES + wave, NGW = G * NWAVES; (void)gw; (void)NGW; \
    const size_t gtid = (size_t)bx * NTHREADS + tid, gsz = (size_t)G * NTHREADS; (void)gtid; (void)gsz;
#define x_prompt (ARGP(0))
#define x_sample (ARGP(1))
#define cache_swa_k (ARGP(2))
#define cache_swa_v (ARGP(3))
#define cache_mem_k (ARGP(4))
#define cache_mem_v (ARGP(5))
#define state_re (ARGP(6))
#define state_im (ARGP(7))
#define mem_prompt (ARGP(8))
#define rel_bias (ARGP(9))
#define ff1_pre_g (ARGP(10))
#define ff1_post_g (ARGP(11))
#define w_ff1_in (ARGP(12))
#define w_ff1_out (ARGP(13))
#define mix_pre_g (ARGP(14))
#define mix_post_g (ARGP(15))
#define w_in (ARGP(16))
#define mem_norm_g (ARGP(17))
#define w_mem_kv (ARGP(18))
#define attn_sink (ARGP(19))
#define lam_re (ARGP(20))
#define lam_im (ARGP(21))
#define log_dt (ARGP(22))
#define b_re (ARGP(23))
#define b_im (ARGP(24))
#define c_re (ARGP(25))
#define c_im (ARGP(26))
#define d_skip (ARGP(27))
#define w_ssm_glu (ARGP(28))
#define w_attn_br (ARGP(29))
#define w_mem_br (ARGP(30))
#define w_out (ARGP(31))
#define ff2_pre_g (ARGP(32))
#define ff2_post_g (ARGP(33))
#define w_ff2_in (ARGP(34))
#define w_ff2_out (ARGP(35))
#define GRID_BAR() do { PHASE_PTRS(); XcdBarrier b_; b_.bar = ctl + CW_BAR; b_.x = xb_xcc_id(); b_.st = (volatile LAS unsigned*)(lds + MISC_OFF) + 8; xcd_barrier(b_); } while (0)
    { PHASE_PTRS();
      if (tid < 64) ((LAS unsigned*)(lds + MISC_OFF))[tid] = 0u;
      __syncthreads();
      (void)xcd_barrier_post(ctl + CW_BAR, (volatile LAS unsigned*)(lds + MISC_OFF) + 8);
      grid.sync(); }
    {
        PHASE_PTRS();
        LAS float* scr = (LAS float*)(lds + wave * 8704);
        constexpr int I_1A = 16 * 176, I_1B = 44 * 32, I_IN = 16 * 152, I_BA = 8 * 32, I_BG = 8 * 64, I_SQ = 16 * 32;
        constexpr int NITEMS = 2 * I_1A + 2 * I_1B + I_IN + 2 * I_BA + I_BG + 2 * I_SQ;
        for (int it = gw; it < NITEMS; it += NGW) {
            int r = it;
            if (r < 2 * I_1A) { const int second = r >= I_1A; if (second) r -= I_1A; const int kb = r / 176, nb = r % 176, n0 = nb * 32;
                const int j = n0 < DFF ? n0 : n0 - DFF; const int drow = (j >> 7) * 256 + (n0 < DFF ? 0 : 128) + (j & 127);
                tr_item(second ? w_ff2_in : w_ff1_in, 2 * DFF, kb * 64, n0, second ? ff2_pre_g : ff1_pre_g, second ? W2A : W1A, 1024, drow, scr, lane); continue; }
            r -= 2 * I_1A;
            if (r < 2 * I_1B) { const int second = r >= I_1B; if (second) r -= I_1B; const int kb = r / 32, nb = r % 32;
                tr_item(second ? w_ff2_out : w_ff1_out, 1024, kb * 64, nb * 32, nullptr, second ? W2B : W1B, DFF, nb * 32, scr, lane); continue; }
            r -= 2 * I_1B;
            if (r < I_IN) { const int kb = r / 152, nb = r % 152; tr_item(w_in, NIN, kb * 64, nb * 32, mix_pre_g, WIN, 1024, nb * 32, scr, lane); continue; }
            r -= I_IN;
            if (r < 2 * I_BA) { const int second = r >= I_BA; if (second) r -= I_BA; const int kb = r / 32, nb = r % 32, n0 = nb * 32, p = n0 >> 7;
                tr_item(second ? w_mem_br : w_attn_br, 1024, kb * 64, n0, nullptr, second ? WBM : WBA, 512, (p & 3) * 256 + (p >> 2) * 128 + (n0 & 127), scr, lane); continue; }
            r -= 2 * I_BA;
            if (r < I_BG) { const int kb = r / 64, nb = r % 64, n0 = nb * 32; const int j = n0 & 1023;
                tr_item(w_ssm_glu, 2048, kb * 64, n0, nullptr, WBG, 512, (j >> 7) * 256 + (n0 >= 1024 ? 128 : 0) + (j & 127), scr, lane); continue; }
            r -= I_BG;
            { const int second = r >= I_SQ; if (second) r -= I_SQ; const int kb = r / 32, nb = r % 32;
              tr_item(second ? w_mem_kv : w_out, 1024, kb * 64, nb * 32, second ? mem_norm_g : nullptr, second ? WMKV : WOUT, 1024, nb * 32, scr, lane); }
        }
        for (int m = gw; m < MT; m += NGW) rms_row_to_bf16(m < TP ? x_prompt + (size_t)m * DM : x_sample + (size_t)(m - TP) * DM, XN + (size_t)m * DM, lane);
        for (int m = gw; m < 512; m += NGW) rms_row_to_bf16(mem_prompt + (size_t)m * DM, MEMN + (size_t)m * DM, lane);
        for (int it = gw; it < 32 * 33; it += NGW) ssm_small_tables(it / 33, it % 33, lane, lam_re, lam_im, log_dt, b_re, b_im, c_re, c_im, d_skip, POW, BBAR, KTAB);
        for (size_t it = gtid; it < 8 * 256 + 8; it += gsz) {
            if (it < 2048) { const int h = (int)it >> 8, idx = (int)it & 255; BIAS[it] = idx < 255 ? rel_bias[T5_BUCKET[idx] * 8 + h] * LOG2E : 0.f; }
            else BIAS[it] = attn_sink[it - 2048] * LOG2E;
        }
    }
    GRID_BAR();

#pragma unroll 1
    for (int pass = 0; pass < 2; ++pass) {
        { PHASE_PTRS(); SchedMN S; S.init(MT, 2 * DFF, G, bx, XN, 1024, pass ? W2A : W1A, 1024); EpiSwiglu E{ACT}; pg8::gemm_phase(lds, 1024, 1024, 1024, S, E); }
        if (pass == 0) { PHASE_PTRS(); SchedMN S; S.init(512, 1024, G, bx, MEMN, 1024, WMKV, 1024); EpiMemKV E{out + OUT_MKP, out + OUT_MVP, MKV}; pg8::gemm_phase(lds, 1024, 1024, 1024, S, E); }
        GRID_BAR();
        { PHASE_PTRS(); SchedMN S; S.init(MT, 1024, G, bx, ACT, DFF, pass ? W2B : W1B, DFF); EpiF32 E{OB, 1024}; pg8::gemm_phase(lds, DFF, DFF, DFF, S, E); }
        GRID_BAR();
        { PHASE_PTRS(); const float* gp = pass ? ff2_post_g : ff1_post_g;
          for (int m = gw; m < MT; m += NGW) { const float* xin = pass ? out + (size_t)m * DM : (m < TP ? x_prompt + (size_t)m * DM : x_sample + (size_t)(m - TP) * DM);
              resid_row(OB + (size_t)m * DM, xin, gp, 0.5f, out + (size_t)m * DM, pass ? nullptr : XN + (size_t)m * DM, lane); } }
        if (pass == 1) break;
        { PHASE_PTRS(); ssm_expand_tables(gtid, gsz, POW, BBAR, KTAB, c_re, c_im, TG, MGT); }
        GRID_BAR();
        { PHASE_PTRS(); SchedMN S; S.init(MT, NIN, G, bx, XN, 1024, WIN, 1024); EpiWin E{Q, KK, VV, UG, QM, GATES, out}; pg8::gemm_phase(lds, 1024, 1024, 1024, S, E); }
        GRID_BAR();
        { PHASE_PTRS(); SchedGrp S; S.init(1, G, bx, UG, UGW, (size_t)NCHP * UGW * 2, MGT, 512, (size_t)256 * 512 * 2); EpiLE E{LE}; pg8::gemm_phase(lds, 512, UGW, 512, S, E); }
        { PHASE_PTRS();
        for (;;) { const int u = queue_next(ctl + CW_Q0, MISC, tid); if (u >= 1024 + 32) break;
            if (u < 1024) swa_prompt_unit(u, lds, Q, KK, VV, BIAS, tid, wave, lane); else swa_sample_unit(u - 1024, lds, Q, KK, VV, cache_swa_k, cache_swa_v, BIAS, tid, wave, lane); } }
        GRID_BAR();
        { PHASE_PTRS();
        if (bx < 8) ssm_carry_prompt(bx * NTHREADS + tid, POW, LE, UG, out);
        for (size_t it = gtid; it < 65536; it += gsz) ssm_carry_sample((int)it, POW, LE, UG, state_re, state_im, out);
        for (;;) { const int u = queue_next(ctl + CW_Q1, MISC, tid); if (u >= 512 + 128) break;
            if (u < 512) { const int h = u & 3, qb = (u >> 2) & 63, b = u >> 8; SrcCrossPrompt src{MKV, b, h, 0};
                cross_unit(src, true, QM + ((size_t)b * SEQ + qb * 256 + wave * 32 + (lane & 31)) * 512 + h * 128, lds, tid, lane); }
            else { const int v = u - 512, h = v & 3, db = v >> 2; SrcCrossSample src{cache_mem_k, cache_mem_v, db, h, 0};
                cross_unit(src, wave == 0, QM + ((size_t)TP + db * 32 + (lane & 31)) * 512 + h * 128, lds, tid, lane); } } }
        GRID_BAR();
        { PHASE_PTRS(); SchedGrp S; S.init(2, G, bx, UG, UGW, (size_t)NCHP * UGW * 2, TG, UGW, (size_t)512 * UGW * 2); EpiY E{YB}; pg8::gemm_phase(lds, UGW, UGW, UGW, S, E); }
        GRID_BAR();
        { PHASE_PTRS(); SchedBr S{G, bx, (const char*)ws}; EpiBr E{GATES, MERGED}; pg8::gemm_phase(lds, 512, 512, 512, S, E); }
        GRID_BAR();
        { PHASE_PTRS(); SchedMN S; S.init(MT, 1024, G, bx, MERGED, 1024, WOUT, 1024); EpiF32 E{OB, 1024}; pg8::gemm_phase(lds, 1024, 1024, 1024, S, E); }
        GRID_BAR();
        { PHASE_PTRS();
        for (int m = gw; m < MT; m += NGW) resid_row(OB + (size_t)m * DM, out + (size_t)m * DM, mix_post_g, 1.0f, out + (size_t)m * DM, XN + (size_t)m * DM, lane); }
        GRID_BAR();
    }
}

#undef ARGP
#undef x_prompt
#undef x_sample
#undef cache_swa_k
#undef cache_swa_v
#undef cache_mem_k
#undef cache_mem_v
#undef state_re
#undef state_im
#undef mem_prompt
#undef rel_bias
#undef ff1_pre_g
#undef ff1_post_g
#undef w_ff1_in
#undef w_ff1_out
#undef mix_pre_g
#undef mix_post_g
#undef w_in
#undef mem_norm_g
#undef w_mem_kv
#undef attn_sink
#undef lam_re
#undef lam_im
#undef log_dt
#undef b_re
#undef b_im
#undef c_re
#undef c_im
#undef d_skip
#undef w_ssm_glu
#undef w_attn_br
#undef w_mem_br
#undef w_out
#undef ff2_pre_g
#undef ff2_post_g
#undef w_ff2_in
#undef w_ff2_out
extern "C" void kernel_launch(void* const* d_in, const int* in_sizes, int n_in, void* d_out, int out_size, void* d_ws, size_t ws_size, hipStream_t stream) {
    static int grid_blocks = 0;
    if (!grid_blocks) {
        int dev = 0, cus = 0, per_cu = 0;
        (void)hipGetDevice(&dev);
        (void)hipDeviceGetAttribute(&cus, hipDeviceAttributeMultiprocessorCount, dev);
        (void)hipFuncSetAttribute((const void*)fwd_megakernel, hipFuncAttributeMaxDynamicSharedMemorySize, LDS_BYTES);
        (void)hipOccupancyMaxActiveBlocksPerMultiprocessor(&per_cu, (const void*)fwd_megakernel, NTHREADS, LDS_BYTES);
        (void)hipGetLastError();
        grid_blocks = cus;
        fprintf(stderr, "kernel_launch: cus %d occupancy/CU %d grid %d n_in %d ws %zu (need %zu) out %d\n", cus, per_cu, grid_blocks, n_in, ws_size, (size_t)WS_END, out_size);
        if (n_in != 36 || ws_size < WS_END || out_size != (int)OUT_TOTAL || per_cu < 1) { fprintf(stderr, "kernel_launch: unexpected problem shape / workspace; nothing launched\n"); grid_blocks = -1; }
    }
    if (grid_blocks < 0) return;
    (void)hipMemsetAsync((char*)d_ws + WS_CTL, 0, CTL_BYTES, stream);
    Args a{};
    for (int i = 0; i < 36; ++i) a.in[i] = (const float*)d_in[i];
    a.out = (float*)d_out; a.ws = (unsigned char*)d_ws;
    void* args[] = {&a};
    hipError_t e = hipLaunchCooperativeKernel((const void*)fwd_megakernel, dim3(grid_blocks), dim3(NTHREADS), args, LDS_BYTES, stream);
    if (e != hipSuccess) fprintf(stderr, "cooperative launch failed: %s (grid %d)\n", hipGetErrorString(e), grid_blocks);
}
```
